# Optimizing an MI355X kernel written in HIP

```python
import math
import jax, jax.numpy as jnp
from jax import lax
import numpy as np

D_MODEL = 2048
BATCH = 16
SEQ = 2048
DEPTH = 2

GRID_W = 64
CTX_LEN = 256
Q_BLOCK = 128
ROPE_THETA = 10000.0
EPS = 1e-6
GN_EPS = 1e-5

A_HEADS = D_MODEL // 256
A_DIM = 64
A_VDIM = 2 * A_DIM
B_HEADS = D_MODEL // 512
B_QK = 128
B_V = 2 * B_QK
RET_CHUNK = 128
C_HEADS = D_MODEL // 256
C_KV_HEADS = C_HEADS // 4
C_GROUP = C_HEADS // C_KV_HEADS
C_DIM = 128

N_BRANCH = 3
BRANCH_W = A_HEADS * A_VDIM

IN_SIZES = (A_HEADS * 2 * A_DIM, A_HEADS * 2 * A_DIM, A_HEADS * A_VDIM,
            B_HEADS * B_QK, B_HEADS * B_QK, B_HEADS * B_V, B_HEADS * B_V,
            C_HEADS * C_DIM, C_KV_HEADS * C_DIM, C_KV_HEADS * C_DIM)
W_IN = sum(IN_SIZES)
IN_OFFSETS = tuple(int(o) for o in np.cumsum(IN_SIZES)[:-1])

FF = 256 * ((8 * D_MODEL // 3 + 255) // 256)
N_EXPERTS = 8
TOP_K = 2
N_DENSE = (DEPTH + 1) // 2
N_MOE = DEPTH // 2

kernel_name = 'hybrid_diffattn_retention_gqa_moe_dit'


def rmsnorm(x, g):
    xf = x.astype(jnp.float32)
    y = xf * lax.rsqrt(jnp.mean(xf * xf, axis=-1, keepdims=True) + EPS)
    return (y * g.astype(jnp.float32)).astype(x.dtype)


def modulate(h, shift, scale):
    return h * (1.0 + scale) + shift


def split_heads(t, n):
    B, L, _ = t.shape
    return t.reshape(B, L, n, -1).transpose(0, 2, 1, 3)


def merge_heads(t):
    B, H, L, d = t.shape
    return t.transpose(0, 2, 1, 3).reshape(B, L, H * d)


def axial_rope_tables(length, dim):
    rows = length // GRID_W
    row = jnp.repeat(jnp.arange(rows, dtype=jnp.float32), GRID_W)
    col = jnp.tile(jnp.arange(GRID_W, dtype=jnp.float32), rows)
    n = dim // 4
    inv = ROPE_THETA ** (-jnp.arange(n, dtype=jnp.float32) / n)
    ang = jnp.concatenate([row[:, None] * inv, col[:, None] * inv], axis=-1)
    return jnp.cos(ang), jnp.sin(ang)


def apply_rope(x, cos, sin):
    half = x.shape[-1] // 2
    x1, x2 = x[..., :half], x[..., half:]
    return jnp.concatenate([x1 * cos - x2 * sin, x2 * cos + x1 * sin], axis=-1).astype(x.dtype)


def softmax32(s):
    return jax.nn.softmax(s.astype(jnp.float32), axis=-1)


def to_blocks(t):
    L, d = t.shape[-2], t.shape[-1]
    t = t.reshape(t.shape[:-2] + (L // Q_BLOCK, Q_BLOCK, d))
    return jnp.moveaxis(t, -3, 0)


def from_blocks(t):
    t = jnp.moveaxis(t, 0, -3)
    return t.reshape(t.shape[:-3] + (t.shape[-3] * t.shape[-2], t.shape[-1]))


def sweep_query_blocks(fn, *qs):
    out = lax.map(lambda qb: fn(*qb), tuple(to_blocks(q) for q in qs))
    return from_blocks(out)


def diff_attention(q1, q2, k1, k2, v, lam):
    scale = A_DIM ** -0.5
    def block(q1b, q2b):
        p1 = softmax32(jnp.einsum('bhqd,bhkd->bhqk', q1b, k1) * scale)
        p2 = softmax32(jnp.einsum('bhqd,bhkd->bhqk', q2b, k2) * scale)
        return jnp.einsum('bhqk,bhkd->bhqd', p1 - lam * p2, v)
    return sweep_query_blocks(block, q1, q2)


def gqa_attention(q, k, v):
    scale = C_DIM ** -0.5
    def block(qb):
        p = softmax32(jnp.einsum('bhgqd,bhkd->bhgqk', qb, k) * scale)
        return jnp.einsum('bhgqk,bhkd->bhgqd', p, v)
    return sweep_query_blocks(block, q)


def retention_chunkwise(q, k, v, log_gamma, r0):
    B, H, L, dk = q.shape
    dv = v.shape[-1]
    C = RET_CHUNK
    N = L // C
    qc = q.reshape(B, H, N, C, dk)
    kc = k.reshape(B, H, N, C, dk)
    vc = v.reshape(B, H, N, C, dv)
    lg = log_gamma.astype(jnp.float32)
    idx = jnp.arange(C, dtype=jnp.float32)
    diff = idx[:, None] - idx[None, :]
    decay = jnp.where(diff >= 0, jnp.exp(lg[:, None, None] * jnp.maximum(diff, 0.0)), 0.0)
    scores = jnp.einsum('bhncd,bhnmd->bhncm', qc, kc) * decay[:, None]
    o_intra = jnp.einsum('bhncm,bhnme->bhnce', scores, vc)
    zeta = jnp.exp(lg[:, None] * (C - 1 - idx))
    xi = jnp.exp(lg[:, None] * (idx + 1))
    chunk_state = jnp.einsum('bhncd,hc,bhnce->nbhde', kc, zeta, vc)
    g_chunk = jnp.exp(lg * C)[:, None, None]
    def step(r, u):
        return g_chunk * r + u, r
    _, r_prev = lax.scan(step, r0.astype(jnp.float32), chunk_state)
    o_cross = jnp.einsum('bhncd,hc,nbhde->bhnce', qc, xi, r_prev)
    return (o_intra + o_cross).reshape(B, H, L, dv)


def retention_final_state(k, v, log_gamma):
    L = k.shape[2]
    lg = log_gamma.astype(jnp.float32)
    w = jnp.exp(lg[:, None] * (L - 1 - jnp.arange(L, dtype=jnp.float32)))
    return jnp.einsum('bhld,hl,bhle->bhde', k, w, v)


def retention_bidir(q, k, v, log_decay, r_f, r_b):
    flip = lambda t: jnp.flip(t, axis=2)
    fwd = retention_chunkwise(q, k, v, log_decay[0], r_f)
    bwd = flip(retention_chunkwise(flip(q), flip(k), flip(v), log_decay[1], r_b))
    return fwd + bwd


def head_groupnorm(y):
    yf = y.astype(jnp.float32)
    mu = jnp.mean(yf, axis=-1, keepdims=True)
    var = jnp.mean(jnp.square(yf - mu), axis=-1, keepdims=True)
    return (yf - mu) * lax.rsqrt(var + GN_EPS)


def project_heads(p, qk_g, rope64, rope128):
    B, L, _ = p.shape
    aq, ak, av, bq, bk, bv, bg, cq, ck, cv = jnp.split(p, IN_OFFSETS, axis=-1)
    def rot(t, rope):
        return t if rope is None else apply_rope(t, *rope)
    def diff_pair(t):
        t = rot(t.reshape(B, L, A_HEADS, 2, A_DIM).transpose(3, 0, 2, 1, 4), rope64)
        return t[0], t[1]
    aq1, aq2 = diff_pair(aq)
    ak1, ak2 = diff_pair(ak)
    av = split_heads(av, A_HEADS)
    bq = rot(split_heads(bq, B_HEADS), rope128)
    bk = rot(split_heads(bk, B_HEADS), rope128) * (B_QK ** -0.5)
    bv = split_heads(bv, B_HEADS)
    cq = rot(rmsnorm(split_heads(cq, C_HEADS), qk_g[0]), rope128).reshape(B, C_KV_HEADS, C_GROUP, L, C_DIM)
    ck = rot(rmsnorm(split_heads(ck, C_KV_HEADS), qk_g[1]), rope128)
    cv = split_heads(cv, C_KV_HEADS)
    return (aq1, aq2, ak1, ak2, av, bq, bk, bv, bg, cq, ck, cv)


def run_branches(side, keys, r_f, r_b, lam, lam_init, subln_g, log_decay):
    aq1, aq2, _, _, _, bq, bk, bv, bg, cq, _, _ = side
    ak1, ak2, av, ck, cv = keys
    B, _, L, _ = bq.shape
    o_a = merge_heads(rmsnorm(diff_attention(aq1, aq2, ak1, ak2, av, lam), subln_g) * (1.0 - lam_init))
    o_b = merge_heads(head_groupnorm(retention_bidir(bq, bk, bv, log_decay, r_f, r_b))) * jax.nn.silu(bg)
    o_c = merge_heads(gqa_attention(cq, ck, cv).reshape(B, C_HEADS, L, C_DIM))
    return (o_a, o_b, o_c)


def merge_branches(h, outs, w_branch, w_bgate, w_out):
    gates = jax.nn.sigmoid(h @ w_bgate)
    y = gates[..., :D_MODEL] * (outs[0] @ w_branch[0])
    for i in range(1, N_BRANCH):
        y = y + gates[..., i * D_MODEL:(i + 1) * D_MODEL] * (outs[i] @ w_branch[i])
    return y @ w_out


def token_mixer(h_lat, h_ctx, w_in, qk_g, lam_vec, subln_g, log_decay, w_branch, w_bgate, w_out,
                rope64, rope128, lam_init, with_ctx):
    lat = project_heads(h_lat @ w_in, qk_g, rope64, rope128)
    cx = project_heads(h_ctx @ w_in, qk_g, None, None)
    lv = lam_vec.astype(jnp.float32)
    lam = jnp.exp(jnp.sum(lv[0] * lv[1])) - jnp.exp(jnp.sum(lv[2] * lv[3])) + lam_init
    ak1c, ak2c, avc, bkc, bvc, ckc, cvc = cx[2], cx[3], cx[4], cx[6], cx[7], cx[10], cx[11]
    r_f = retention_final_state(bkc, bvc, log_decay[0])
    r_b = retention_final_state(jnp.flip(bkc, axis=2), jnp.flip(bvc, axis=2), log_decay[1])
    cat = lambda a, b: jnp.concatenate([a, b], axis=2)
    keys_lat = (cat(ak1c, lat[2]), cat(ak2c, lat[3]), cat(avc, lat[4]), cat(ckc, lat[10]), cat(cvc, lat[11]))
    y_lat = merge_branches(h_lat, run_branches(lat, keys_lat, r_f, r_b, lam, lam_init, subln_g, log_decay),
                           w_branch, w_bgate, w_out)
    y_ctx = None
    if with_ctx:
        zeros = jnp.zeros_like(r_f)
        y_ctx = merge_branches(h_ctx, run_branches(cx, (ak1c, ak2c, avc, ckc, cvc), zeros, zeros, lam, lam_init,
                                                   subln_g, log_decay), w_branch, w_bgate, w_out)
    return y_lat, y_ctx


def swiglu(h, w_in, w_out):
    g, u = jnp.split(h @ w_in, 2, axis=-1)
    return (jax.nn.silu(g) * u) @ w_out


def moe_swiglu(h, router, w_in, w_out):
    shp = h.shape
    t = h.reshape(-1, shp[-1])
    logits = (t @ router).astype(jnp.float32)
    top_val, top_idx = lax.top_k(logits, TOP_K)
    w = jax.nn.softmax(top_val, axis=-1)
    gates = jnp.sum(jax.nn.one_hot(top_idx, N_EXPERTS, dtype=jnp.float32) * w[..., None], axis=1)
    y = gates[:, 0:1] * swiglu(t, w_in[0], w_out[0])
    for e in range(1, N_EXPERTS):
        y = y + gates[:, e:e + 1] * swiglu(t, w_in[e], w_out[e])
    return y.reshape(shp)


def channel_mixer(i, h, ffn_w_in, ffn_w_out, moe_router, moe_w_in, moe_w_out):
    j = i // 2
    if i % 2 == 0:
        return swiglu(h, ffn_w_in[j], ffn_w_out[j])
    return moe_swiglu(h, moe_router[j], moe_w_in[j], moe_w_out[j])


def setup_inputs(seed: int = 0) -> dict:
    key = jax.random.key(seed)
    ks = jax.random.split(key, 20)
    nrm = lambda k, shape, s: jax.random.normal(k, shape, jnp.float32) * s
    base_decay = jnp.asarray(np.log1p(-(2.0 ** (-5.0 - np.arange(B_HEADS)))), jnp.float32)
    return {
        'x': nrm(ks[0], (BATCH, SEQ, D_MODEL), 1.0),
        'c': nrm(ks[1], (BATCH, D_MODEL), 1.0),
        'ctx': nrm(ks[2], (BATCH, CTX_LEN, D_MODEL), 1.0),
        'c_ctx': nrm(ks[3], (D_MODEL,), 1.0),
        'w_mod': nrm(ks[4], (DEPTH, D_MODEL, 6 * D_MODEL), 0.5 * D_MODEL ** -0.5),
        'b_mod': nrm(ks[5], (DEPTH, 6 * D_MODEL), 0.02),
        'norm_g': 1.0 + nrm(ks[6], (DEPTH, 4, D_MODEL), 0.05),
        'w_in': nrm(ks[7], (DEPTH, D_MODEL, W_IN), D_MODEL ** -0.5),
        'qk_norm_g': 1.0 + nrm(ks[8], (DEPTH, 2, C_DIM), 0.05),
        'diff_lambda': nrm(ks[9], (DEPTH, 4, A_DIM), 0.1),
        'diff_subln_g': 1.0 + nrm(ks[10], (DEPTH, A_VDIM), 0.05),
        'ret_log_decay': base_decay * jnp.exp(nrm(ks[11], (DEPTH, 2, B_HEADS), 0.1)),
        'w_branch': nrm(ks[12], (DEPTH, N_BRANCH, BRANCH_W, D_MODEL), BRANCH_W ** -0.5),
        'w_branch_gate': nrm(ks[13], (DEPTH, D_MODEL, N_BRANCH * D_MODEL), D_MODEL ** -0.5),
        'w_out': nrm(ks[14], (DEPTH, D_MODEL, D_MODEL), D_MODEL ** -0.5),
        'ffn_w_in': nrm(ks[15], (N_DENSE, D_MODEL, 2 * FF), D_MODEL ** -0.5),
        'ffn_w_out': nrm(ks[16], (N_DENSE, FF, D_MODEL), FF ** -0.5),
        'moe_router': nrm(ks[17], (N_MOE, D_MODEL, N_EXPERTS), D_MODEL ** -0.5),
        'moe_w_in': nrm(ks[18], (N_MOE, N_EXPERTS, D_MODEL, 2 * FF), D_MODEL ** -0.5),
        'moe_w_out': nrm(ks[19], (N_MOE, N_EXPERTS, FF, D_MODEL), FF ** -0.5),
    }


def reference(x, c, ctx, c_ctx, w_mod, b_mod, norm_g, w_in, qk_norm_g, diff_lambda, diff_subln_g,
              ret_log_decay, w_branch, w_branch_gate, w_out, ffn_w_in, ffn_w_out, moe_router,
              moe_w_in, moe_w_out):
    L = x.shape[1]
    rope64 = axial_rope_tables(L, A_DIM)
    rope128 = axial_rope_tables(L, C_DIM)
    cond_lat = jax.nn.silu(c)
    cond_ctx = jax.nn.silu(c_ctx)
    s_ctx = ctx
    for i in range(DEPTH):
        with_ctx = i < DEPTH - 1
        lam_init = 0.8 - 0.6 * math.exp(-0.3 * i)
        m_lat = jnp.split((cond_lat @ w_mod[i] + b_mod[i])[:, None, :], 6, axis=-1)
        m_ctx = jnp.split(cond_ctx @ w_mod[i] + b_mod[i], 6, axis=-1)
        h_lat = modulate(rmsnorm(x, norm_g[i, 0]), m_lat[0], m_lat[1])
        h_ctx = modulate(rmsnorm(s_ctx, norm_g[i, 0]), m_ctx[0], m_ctx[1])
        y_lat, y_ctx = token_mixer(h_lat, h_ctx, w_in[i], qk_norm_g[i], diff_lambda[i], diff_subln_g[i],
                                   ret_log_decay[i], w_branch[i], w_branch_gate[i], w_out[i],
                                   rope64, rope128, lam_init, with_ctx)
        x = x + m_lat[2] * rmsnorm(y_lat, norm_g[i, 1])
        if with_ctx:
            s_ctx = s_ctx + m_ctx[2] * rmsnorm(y_ctx, norm_g[i, 1])
        f_lat = channel_mixer(i, modulate(rmsnorm(x, norm_g[i, 2]), m_lat[3], m_lat[4]),
                              ffn_w_in, ffn_w_out, moe_router, moe_w_in, moe_w_out)
        x = x + m_lat[5] * rmsnorm(f_lat, norm_g[i, 3])
        if with_ctx:
            f_ctx = channel_mixer(i, modulate(rmsnorm(s_ctx, norm_g[i, 2]), m_ctx[3], m_ctx[4]),
                                  ffn_w_in, ffn_w_out, moe_router, moe_w_in, moe_w_out)
            s_ctx = s_ctx + m_ctx[5] * rmsnorm(f_ctx, norm_g[i, 3])
    return x
```

```cpp
#include <hip/hip_runtime.h>
#include <cstdio>
#include <cstdint>

#define GAS __attribute__((address_space(1)))
#define LAS __attribute__((address_space(3)))
typedef unsigned short bf16;
typedef short bf16x8 __attribute__((ext_vector_type(8)));
typedef short s16x4 __attribute__((ext_vector_type(4)));
typedef float f32x4 __attribute__((ext_vector_type(4)));
typedef float f32x16 __attribute__((ext_vector_type(16)));
typedef unsigned u32x4 __attribute__((ext_vector_type(4)));
typedef unsigned u32x2 __attribute__((ext_vector_type(2)));

#ifndef I8_GATES
#define I8_GATES 1
#endif
#ifndef I8_P1
#define I8_P1 3
#endif
#ifndef DBG_BRANCH_MASK
#define DBG_BRANCH_MASK 7
#endif

constexpr int D = 2048, NB = 16, SEQ = 2048, CTXL = 256, TPB = SEQ + CTXL, M = NB * TPB;
constexpr int WIN = 7680, FF = 5632, NE = 8, NTOK = NB * SEQ;
constexpr int O_AQ = 0, O_AK = 1024, O_AV = 2048, O_BQ = 3072, O_BK = 3584, O_BV = 4096, O_BG = 5120, O_CQ = 6144, O_CK = 7168, O_CV = 7424;
constexpr int NSLOT = 2 * NTOK + NE * 256;
constexpr float EPS = 1e-6f, GN_EPS = 1e-5f, LOG2E = 1.4426950408889634f;

constexpr size_t MiB = 1u << 20;
constexpr size_t WS_CTL = 0, CTL_ZERO_BYTES = 1 * MiB;
constexpr size_t WS_MVEC = 4 * MiB;
constexpr size_t WS_ROPE = 6 * MiB;
constexpr size_t WS_TOK = 8 * MiB;
constexpr size_t WS_WIN = 10 * MiB;
constexpr size_t WS_WB = WS_WIN + 60 * MiB;
constexpr size_t WS_WG = WS_WB + 24 * MiB;
constexpr size_t WS_WO = WS_WG + 48 * MiB;
constexpr size_t WS_WF1 = WS_WO + 16 * MiB;
constexpr size_t WS_WF2 = WS_WF1 + 44 * MiB;
constexpr size_t WS_WM1 = WS_WF2 + 22 * MiB;
constexpr size_t WS_WM2 = WS_WM1 + 352 * MiB;
constexpr size_t WS_XRES = WS_WM2 + 176 * MiB;
constexpr size_t WS_H = WS_XRES + 288 * MiB;
constexpr size_t WS_HG = WS_H + 144 * MiB;
constexpr size_t WS_S = WS_HG + 264 * MiB;
constexpr size_t S_P = WS_S;
constexpr size_t S_OA = WS_S + 540 * MiB;
constexpr size_t S_OB = WS_S + 684 * MiB;
constexpr size_t S_OCAT = WS_S + 756 * MiB;
constexpr size_t S_BB = WS_S;
constexpr size_t S_Y2 = S_OA;
constexpr size_t S_Y = S_OCAT;
constexpr size_t S_YO = WS_S;
constexpr size_t S_ACT = WS_S;
constexpr size_t S_FO = S_OCAT;
constexpr size_t WS_END = WS_S + 1044 * MiB;
static_assert(WS_END <= (size_t)2800 * MiB, "workspace map");
constexpr size_t T_E = WS_TOK, T_W = T_E + 256 * 1024, T_LP = T_W + 256 * 1024, T_SLOT = T_LP + 256 * 1024, T_SW = T_SLOT + 256 * 1024,
                 T_CNT = T_SW + 512 * 1024, T_TS = T_CNT + 64 * 1024, T_SA = T_TS + 8 * 1024;
static_assert(T_SA + 152 * 1024 <= WS_WIN, "routing / scale tables fit below the weight copies");
constexpr int CW_BAR = 4096;
constexpr size_t CTL_COLMAX = 256 * 1024;
constexpr int QOFF[6] = {0, 11264, 17408, 23552, 31232, 38912};
constexpr size_t WS_SWALL = WS_MVEC + 1792 * 1024;
constexpr size_t WS_SAH = WS_ROPE + 1536 * 1024;
constexpr size_t WS_HQ = WS_XRES + 144 * MiB;

constexpr int RING_BYTES = 131072;
constexpr int MISC_OFF = 135168;
constexpr int LDS_BYTES = 147456;

template <class T> __device__ __forceinline__ T* as_global(T* p) { return (T*)(GAS T*)p; }
__device__ __forceinline__ unsigned f2bf(float f) { unsigned u = __builtin_bit_cast(unsigned, f); return (u + 0x7fffu + ((u >> 16) & 1u)) >> 16; }
__device__ __forceinline__ unsigned pk2(float lo, float hi) { return f2bf(lo) | (f2bf(hi) << 16); }
__device__ __forceinline__ unsigned cvt_pk_bf16(float lo, float hi) { unsigned r; asm volatile("v_cvt_pk_bf16_f32 %0, %1, %2" : "=v"(r) : "v"(lo), "v"(hi)); return r; }
__device__ __forceinline__ float bflo(unsigned u) { return __builtin_bit_cast(float, u << 16); }
__device__ __forceinline__ float bfhi(unsigned u) { return __builtin_bit_cast(float, u & 0xffff0000u); }
__device__ __forceinline__ void unpack8(u32x4 w, float (&v)[8]) { v[0] = bflo(w.x); v[1] = bfhi(w.x); v[2] = bflo(w.y); v[3] = bfhi(w.y); v[4] = bflo(w.z); v[5] = bfhi(w.z); v[6] = bflo(w.w); v[7] = bfhi(w.w); }
__device__ __forceinline__ u32x4 pack8(const float (&v)[8]) { u32x4 w; w.x = cvt_pk_bf16(v[0], v[1]); w.y = cvt_pk_bf16(v[2], v[3]); w.z = cvt_pk_bf16(v[4], v[5]); w.w = cvt_pk_bf16(v[6], v[7]); return w; }
__device__ __forceinline__ float clamp8(float x) { return fminf(fmaxf(x, -448.f), 448.f); }
__device__ __forceinline__ u32x2 pack8_fp8(const float (&v)[8]) {
    unsigned w0 = 0, w1 = 0;
    w0 = __builtin_amdgcn_cvt_pk_fp8_f32(clamp8(v[0]), clamp8(v[1]), w0, false); w0 = __builtin_amdgcn_cvt_pk_fp8_f32(clamp8(v[2]), clamp8(v[3]), w0, true);
    w1 = __builtin_amdgcn_cvt_pk_fp8_f32(clamp8(v[4]), clamp8(v[5]), w1, false); w1 = __builtin_amdgcn_cvt_pk_fp8_f32(clamp8(v[6]), clamp8(v[7]), w1, true);
    return (u32x2){w0, w1};
}
__device__ __forceinline__ u32x2 pack8_i8(const float (&v)[8]) {
    int q[8];
#pragma unroll
    for (int e = 0; e < 8; ++e) { q[e] = (int)__builtin_rintf(v[e]); q[e] = q[e] < -127 ? -127 : (q[e] > 127 ? 127 : q[e]); }
    return (u32x2){(unsigned)(q[0] & 255) | ((unsigned)(q[1] & 255) << 8) | ((unsigned)(q[2] & 255) << 16) | ((unsigned)q[3] << 24),
                   (unsigned)(q[4] & 255) | ((unsigned)(q[5] & 255) << 8) | ((unsigned)(q[6] & 255) << 16) | ((unsigned)q[7] << 24)};
}
__device__ __forceinline__ float sigmoidf_(float x) { return __builtin_amdgcn_rcpf(1.f + __builtin_amdgcn_exp2f(-x * LOG2E)); }
__device__ __forceinline__ float shflx(float v, int o, int lane) { return __builtin_bit_cast(float, __builtin_amdgcn_ds_bpermute((lane ^ o) << 2, __builtin_bit_cast(int, v))); }
__device__ __forceinline__ float wave_sum(float v, int lane) {
#pragma unroll
    for (int o = 1; o < 64; o <<= 1) v += shflx(v, o, lane);
    return v;
}
#define LDS_WAIT() asm volatile("s_waitcnt lgkmcnt(0)" ::: "memory")
#define VM_WAIT() asm volatile("s_waitcnt vmcnt(0)" ::: "memory")

#define XB_TMO      128
#define XB_XCNT(j)  (256  + 64 * (j))
#define XB_XSUB(j)  (1280 + 64 * (j))
#define XB_XGEN(j)  (2304 + 64 * (j))
#define XB_TOP      3328
#define XB_TOPGEN   3392
#define XCD_BAR_WORDS 3456
#define XB_SPIN_CAP (1u << 20)
__device__ __forceinline__ unsigned xb_ld(unsigned* p)              { return __hip_atomic_load((GAS unsigned*)p, __ATOMIC_RELAXED, __HIP_MEMORY_SCOPE_AGENT); }
__device__ __forceinline__ unsigned xb_add(unsigned* p, unsigned v) { return __hip_atomic_fetch_add((GAS unsigned*)p, v, __ATOMIC_RELAXED, __HIP_MEMORY_SCOPE_AGENT); }
__device__ __forceinline__ unsigned xb_xcc_id() { return (unsigned)__builtin_amdgcn_s_getreg((3 << 11) | 20) & 0xFu; }
#define XB_SPIN(cond, bar) do { unsigned _sp = 0; while (cond) { __builtin_amdgcn_s_sleep(1); \
    if ((++_sp & 255u) == 0u) { if (xb_ld(&(bar)[XB_TMO])) break; if (_sp > XB_SPIN_CAP) { xb_add(&(bar)[XB_TMO], 1u); break; } } } } while (0)
struct XcdBarrier { unsigned* bar; unsigned x; volatile LAS unsigned* st; };
__device__ __forceinline__ XcdBarrier xcd_barrier_post(unsigned* bar, volatile LAS unsigned* st) {
    XcdBarrier b; b.bar = bar; b.x = xb_xcc_id(); b.st = st;
    if (threadIdx.x == 0) (void)xb_add(&as_global(bar)[XB_XCNT(b.x)], 1u);
    return b;
}
__device__ __forceinline__ void xcd_barrier_complete(unsigned* bar, unsigned x, unsigned& nloc, unsigned& nx) {
    const unsigned G = gridDim.x * gridDim.y * gridDim.z;
    unsigned sum, cnt, mine, sp = 0u;
    for (;;) {
        sum = 0u; cnt = 0u; mine = 0u;
#pragma unroll
        for (unsigned j = 0; j < 16; ++j) { const unsigned c = xb_ld(&bar[XB_XCNT(j)]); sum += c; cnt += (c > 0u) ? 1u : 0u; mine = (j == x) ? c : mine; }
        if (sum == G) break;
        __builtin_amdgcn_s_sleep(1);
        if ((++sp & 255u) == 0u) { if (xb_ld(&bar[XB_TMO])) break; if (sp > XB_SPIN_CAP) { xb_add(&bar[XB_TMO], 1u); break; } }
    }
    nloc = mine > 0u ? mine : 1u; nx = cnt > 0u ? cnt : 1u;
}
__device__ __forceinline__ void xcd_barrier(const XcdBarrier& b) {
    asm volatile("s_waitcnt vmcnt(0)" ::: "memory");
    __syncthreads();
    if (threadIdx.x == 0) {
        unsigned* bar = as_global(b.bar);
        __builtin_amdgcn_s_waitcnt(0);
        unsigned nloc = b.st[0], nx = b.st[1];
        if (nloc == 0u) { xcd_barrier_complete(bar, b.x, nloc, nx); b.st[0] = nloc; b.st[1] = nx; }
        const unsigned old = xb_add(&bar[XB_XSUB(b.x)], 1u);
        const unsigned gen = old / nloc;
        if (old + 1u == (gen + 1u) * nloc) {
            __builtin_amdgcn_fence(__ATOMIC_RELEASE, "agent");
            asm volatile("s_waitcnt vmcnt(0)" ::: "memory");
            const unsigned og = xb_add(&bar[XB_TOP], 1u);
            const unsigned tg = og / nx;
            if (og + 1u == (tg + 1u) * nx) xb_add(&bar[XB_TOPGEN], 1u);
            else XB_SPIN(xb_ld(&bar[XB_TOPGEN]) == tg, bar);
            __builtin_amdgcn_fence(__ATOMIC_ACQUIRE, "agent");
            xb_add(&bar[XB_XGEN(b.x)], 1u);
            asm volatile("s_waitcnt vmcnt(0)" ::: "memory");
        } else {
            XB_SPIN(xb_ld(&bar[XB_XGEN(b.x)]) == gen, bar);
            __builtin_amdgcn_fence(__ATOMIC_ACQUIRE, "agent");
            asm volatile("s_waitcnt vmcnt(0)" ::: "memory");
        }
    }
    __syncthreads();
}

namespace pg8 {
constexpr int BM = 256, BK = 64, HALF = 128, HTB = HALF * BK * 2;
__device__ __forceinline__ int lds_byte(int r, int c) { const int st = (r >> 4) * 2 + (c >> 5), rr = r & 15, cc = c & 31, ob = rr * 64 + cc * 2; return st * 1024 + (ob ^ (((ob >> 9) & 1) << 5)); }
__device__ __forceinline__ void stage_rc(int b, int& R, int& C) { const int st = b / 1024, sb = b % 1024, swz = sb ^ (((sb >> 9) & 1) << 5); R = (st >> 1) * 16 + swz / 64; C = (st & 1) * 32 + (swz % 64) / 2; }
__device__ __forceinline__ int perm32(int rho) { const int n = rho >> 4, i = rho & 15; return 8 * (i >> 2) + 4 * n + (i & 3); }

struct Unit { int pm, pn, g; };
struct Sched {
    const char* A; const char* B; int ldaB, kB, nMv, nN, G, c, skipctx, npg, acolstep; const LAS int* ts; size_t bgstride; int nextra;
    __device__ __forceinline__ bool next(int i, Unit& u) const {
        const int nmain = nMv * nN, nwg = nmain + nextra; const long L = (long)i * G + c; if (L >= nwg) return false;
        int wgid = (int)L; { const int q = nwg / 8, r = nwg % 8, xcd = wgid % 8, off = wgid / 8; wgid = (xcd < r ? xcd * (q + 1) : r * (q + 1) + (xcd - r) * q) + off; }
        if (wgid >= nmain) { const int e = wgid - nmain, j = e & 15; u.pm = 9 * (e >> 4); u.pn = j < 8 ? 4 + j : (j < 14 ? 6 + j : 14 + j); u.g = 0; return true; }
        const int nig = 8 * nN, gid = wgid / nig, fm = gid * 8, gsz = (nMv - fm) < 8 ? (nMv - fm) : 8;
        const int pmv = fm + ((wgid % nig) % gsz); u.pn = (wgid % nig) / gsz;
        u.pm = skipctx ? pmv + (pmv >> 3) + 1 : pmv;
        int g = 0;
        if (ts) {
#pragma unroll
            for (int e = 1; e < 8; ++e) g += (pmv >= ts[e]) ? 1 : 0; }
        u.g = g; return true;
    }
    __device__ __forceinline__ const char* Aptr(const Unit& u) const { return A + (size_t)u.pm * 256 * ldaB + (size_t)(u.pn / npg) * acolstep; }
    __device__ __forceinline__ const char* Bptr(const Unit& u) const { return B + (size_t)u.g * bgstride + (size_t)u.pn * 256 * kB; }
};

typedef f32x4 Acc[2][2][4][2];
typedef int v8i __attribute__((ext_vector_type(8)));
typedef int v4i __attribute__((ext_vector_type(4)));

template <bool I8> __device__ __forceinline__ f32x4 accval(const f32x4& a, const f32x4& sc) { if constexpr (I8) return __builtin_convertvector(__builtin_bit_cast(v4i, a), f32x4) * sc; else return a * sc; }
template <bool I8> struct EpiStore {   static constexpr int NSTORES = 16;
    bf16* O; int ldc; const float* rowscale; float scale; const float* sa; const float* sw;
    __device__ __forceinline__ void operator()(const Acc& acc, const Unit& u, int wr, int wc, int fr, int fq) const {
        const int row0 = u.pm * BM + wr * 64 + fr, col0 = u.pn * BM + wc * 32 + 8 * fq;
        f32x4 cs[2][2];
#pragma unroll
        for (int bj = 0; bj < 2; ++bj)
#pragma unroll
            for (int n = 0; n < 2; ++n) cs[bj][n] = I8 ? *(const f32x4*)(sw + col0 + bj * HALF + 4 * n) : (f32x4){1.f, 1.f, 1.f, 1.f};
        float rs_[8];
#pragma unroll
        for (int i = 0; i < 8; ++i) { const int row = row0 + (i >> 2) * HALF + (i & 3) * 16; rs_[i] = I8 ? sa[row] : (rowscale ? rowscale[row] * scale : scale); }
        asm volatile("" : "+v"(rs_[0]), "+v"(rs_[1]), "+v"(rs_[2]), "+v"(rs_[3]), "+v"(rs_[4]), "+v"(rs_[5]), "+v"(rs_[6]), "+v"(rs_[7]));
#pragma unroll
        for (int ai = 0; ai < 2; ++ai)
#pragma unroll
            for (int m = 0; m < 4; ++m) { const int row = row0 + ai * HALF + m * 16; const float s = rs_[ai * 4 + m]; bf16* rowp = O + (size_t)row * ldc + col0;
#pragma unroll
                for (int bj = 0; bj < 2; ++bj) { const f32x4 v0 = accval<I8>(acc[ai][bj][m][0], cs[bj][0]) * s, v1 = accval<I8>(acc[ai][bj][m][1], cs[bj][1]) * s;
                    u32x4 w; w.x = cvt_pk_bf16(v0[0], v0[1]); w.y = cvt_pk_bf16(v0[2], v0[3]); w.z = cvt_pk_bf16(v1[0], v1[1]); w.w = cvt_pk_bf16(v1[2], v1[3]);
                    *(u32x4*)(rowp + bj * HALF) = w; } }
    }
};
template <bool I8> struct EpiG2 {      static constexpr int NSTORES = 16;
    bf16* Y2; const bf16* BB; const float* sa; const float* sw;
    __device__ __forceinline__ void operator()(const Acc& acc, const Unit& u, int wr, int wc, int fr, int fq) const {
        const int row0 = u.pm * BM + wr * 64 + fr, col0 = u.pn * BM + wc * 32 + 8 * fq;
        f32x4 cs[2][2];
#pragma unroll
        for (int bj = 0; bj < 2; ++bj)
#pragma unroll
            for (int n = 0; n < 2; ++n) cs[bj][n] = I8 ? *(const f32x4*)(sw + col0 + bj * HALF + 4 * n) : (f32x4){1.f, 1.f, 1.f, 1.f};
        float rs_[8];
#pragma unroll
        for (int i = 0; i < 8; ++i) { const int row = row0 + (i >> 2) * HALF + (i & 3) * 16; rs_[i] = I8 ? sa[row] : 1.f; }
        asm volatile("" : "+v"(rs_[0]), "+v"(rs_[1]), "+v"(rs_[2]), "+v"(rs_[3]), "+v"(rs_[4]), "+v"(rs_[5]), "+v"(rs_[6]), "+v"(rs_[7]));
#pragma unroll
        for (int ai = 0; ai < 2; ++ai) {
            u32x4 bv[4][2];
#pragma unroll
            for (int m = 0; m < 4; ++m)
#pragma unroll
                for (int bj = 0; bj < 2; ++bj) bv[m][bj] = *(const u32x4*)(BB + (size_t)(row0 + ai * HALF + m * 16) * 6144 + 4096 + col0 + bj * HALF);
            asm volatile("" : "+v"(bv[0][0]), "+v"(bv[0][1]), "+v"(bv[1][0]), "+v"(bv[1][1]), "+v"(bv[2][0]), "+v"(bv[2][1]), "+v"(bv[3][0]), "+v"(bv[3][1]));
#pragma unroll
            for (int m = 0; m < 4; ++m) { const int row = row0 + ai * HALF + m * 16; const float ra = rs_[ai * 4 + m];
#pragma unroll
                for (int bj = 0; bj < 2; ++bj) { const int col = col0 + bj * HALF;
                    float b[8]; unpack8(bv[m][bj], b);
                    const f32x4 a0 = accval<I8>(acc[ai][bj][m][0], cs[bj][0]) * ra, a1 = accval<I8>(acc[ai][bj][m][1], cs[bj][1]) * ra; float o[8];
#pragma unroll
                    for (int j = 0; j < 4; ++j) { o[j] = sigmoidf_(a0[j]) * b[j]; o[4 + j] = sigmoidf_(a1[j]) * b[4 + j]; }
                    *(u32x4*)(Y2 + (size_t)row * 2048 + col) = pack8(o); } } }
    }
};
template <bool I8> struct EpiG01 {     static constexpr int NSTORES = 8;
    bf16* Y; const bf16* Y2; const bf16* BB; int m0, m1, m2; const float* sa; const float* sw;
    __device__ __forceinline__ void operator()(const Acc& acc, const Unit& u, int wr, int wc, int fr, int fq) const {
        const int row0 = u.pm * BM + wr * 64 + fr, col = u.pn * HALF + wc * 32 + 8 * fq, bcol = u.pn * BM + wc * 32 + 8 * fq;
        f32x4 cs[2][2];
#pragma unroll
        for (int bj = 0; bj < 2; ++bj)
#pragma unroll
            for (int n = 0; n < 2; ++n) cs[bj][n] = I8 ? *(const f32x4*)(sw + bcol + bj * HALF + 4 * n) : (f32x4){1.f, 1.f, 1.f, 1.f};
        float rs_[8];
#pragma unroll
        for (int i = 0; i < 8; ++i) { const int row = row0 + (i >> 2) * HALF + (i & 3) * 16; rs_[i] = I8 ? sa[row] : 1.f; }
        asm volatile("" : "+v"(rs_[0]), "+v"(rs_[1]), "+v"(rs_[2]), "+v"(rs_[3]), "+v"(rs_[4]), "+v"(rs_[5]), "+v"(rs_[6]), "+v"(rs_[7]));
#pragma unroll
        for (int ai = 0; ai < 2; ++ai) {
            u32x4 yv[4], b0v[4], b1v[4];
#pragma unroll
            for (int m = 0; m < 4; ++m) { const size_t row = (size_t)(row0 + ai * HALF + m * 16);
                yv[m] = *(const u32x4*)(Y2 + row * 2048 + col); b0v[m] = *(const u32x4*)(BB + row * 6144 + col); b1v[m] = *(const u32x4*)(BB + row * 6144 + 2048 + col); }
            asm volatile("" : "+v"(yv[0]), "+v"(yv[1]), "+v"(yv[2]), "+v"(yv[3]), "+v"(b0v[0]), "+v"(b0v[1]), "+v"(b0v[2]), "+v"(b0v[3]), "+v"(b1v[0]), "+v"(b1v[1]), "+v"(b1v[2]), "+v"(b1v[3]));
#pragma unroll
            for (int m = 0; m < 4; ++m) { const int row = row0 + ai * HALF + m * 16; const float ra = rs_[ai * 4 + m];
                float y2[8], b0[8], b1[8], o[8];
                unpack8(yv[m], y2); unpack8(b0v[m], b0); unpack8(b1v[m], b1);
                const f32x4 g00 = accval<I8>(acc[ai][0][m][0], cs[0][0]) * ra, g01 = accval<I8>(acc[ai][0][m][1], cs[0][1]) * ra, g10 = accval<I8>(acc[ai][1][m][0], cs[1][0]) * ra, g11 = accval<I8>(acc[ai][1][m][1], cs[1][1]) * ra;
#pragma unroll
                for (int j = 0; j < 4; ++j) {
                    o[j] = (m2 ? y2[j] : 0.f) + (m0 ? sigmoidf_(g00[j]) * b0[j] : 0.f) + (m1 ? sigmoidf_(g10[j]) * b1[j] : 0.f);
                    o[4 + j] = (m2 ? y2[4 + j] : 0.f) + (m0 ? sigmoidf_(g01[j]) * b0[4 + j] : 0.f) + (m1 ? sigmoidf_(g11[j]) * b1[4 + j] : 0.f); }
                *(u32x4*)(Y + (size_t)row * 2048 + col) = pack8(o); } }
    }
};
template <bool FP8OUT, bool INT8IN> struct EpiSwiGLU {
    static constexpr bool WIDE = false; static constexpr int NSTORES = 8;
    void* ACTv; float scale; const float* sa; const float* sw;
    __device__ __forceinline__ void operator()(const Acc& acc, const Unit& u, int wr, int wc, int fr, int fq) const {
        const int row0 = u.pm * BM + wr * 64 + fr, col = u.pn * HALF + wc * 32 + 8 * fq, bcol = u.pn * BM + wc * 32 + 8 * fq;
        f32x4 sg0 = {scale, scale, scale, scale}, sg1 = sg0, su0 = sg0, su1 = sg0;
        if constexpr (INT8IN) { sg0 = *(const f32x4*)(sw + bcol); sg1 = *(const f32x4*)(sw + bcol + 4); su0 = *(const f32x4*)(sw + bcol + HALF); su1 = *(const f32x4*)(sw + bcol + HALF + 4); }
        float rs_[8];
#pragma unroll
        for (int i = 0; i < 8; ++i) { const int row = row0 + (i >> 2) * HALF + (i & 3) * 16; rs_[i] = INT8IN ? sa[row] : 1.f; }
        asm volatile("" : "+v"(rs_[0]), "+v"(rs_[1]), "+v"(rs_[2]), "+v"(rs_[3]), "+v"(rs_[4]), "+v"(rs_[5]), "+v"(rs_[6]), "+v"(rs_[7]));
#pragma unroll
        for (int ai = 0; ai < 2; ++ai)
#pragma unroll
            for (int m = 0; m < 4; ++m) { const int row = row0 + ai * HALF + m * 16; float o[8];
                f32x4 g0, g1, u0, u1;
                if constexpr (INT8IN) { const float ra = rs_[ai * 4 + m];
                    g0 = __builtin_convertvector(__builtin_bit_cast(v4i, acc[ai][0][m][0]), f32x4) * sg0 * ra; g1 = __builtin_convertvector(__builtin_bit_cast(v4i, acc[ai][0][m][1]), f32x4) * sg1 * ra;
                    u0 = __builtin_convertvector(__builtin_bit_cast(v4i, acc[ai][1][m][0]), f32x4) * su0 * ra; u1 = __builtin_convertvector(__builtin_bit_cast(v4i, acc[ai][1][m][1]), f32x4) * su1 * ra; }
                else { g0 = acc[ai][0][m][0] * sg0; g1 = acc[ai][0][m][1] * sg1; u0 = acc[ai][1][m][0] * su0; u1 = acc[ai][1][m][1] * su1; }
#pragma unroll
                for (int j = 0; j < 4; ++j) { o[j] = g0[j] * sigmoidf_(g0[j]) * u0[j]; o[4 + j] = g1[j] * sigmoidf_(g1[j]) * u1[j]; }
                if constexpr (FP8OUT) *(u32x2*)((unsigned char*)ACTv + (size_t)row * FF + col) = pack8_fp8(o);
                else *(u32x4*)((bf16*)ACTv + (size_t)row * FF + col) = pack8(o); }
    }
};

template <class Epi, int KIND>
__device__ __forceinline__ void gemm_phase(LAS unsigned char* lds, const Sched& S, const Epi& E, const int tid) {
    const int wid = __builtin_amdgcn_readfirstlane(tid >> 6), lane = tid & 63, wr = wid >> 2, wc = wid & 3, fr = lane & 15, fq = lane >> 4;
    const int kB = S.kB, nt = kB / 128;
    unsigned voffA[2], voffB[2];
#pragma unroll
    for (int i = 0; i < 2; ++i) { int R, C; stage_rc(tid * 16 + i * 8192, R, C); const int Rb = (R & ~31) + perm32(R & 31);
        voffA[i] = (unsigned)(R * S.ldaB + 2 * C); voffB[i] = (unsigned)(Rb * kB + 2 * C); }
    const size_t kstep = (size_t)(BK * 2);
    const size_t hstepA = (size_t)HALF * S.ldaB, hstepB = (size_t)HALF * kB;
    const unsigned ldsw = (unsigned)wid * 1024u;
    const int aoff = lds_byte(wr * 64 + fr, fq * 8), boff = lds_byte(wc * 32 + fr, fq * 8);
#define PG8_SA(b, h) (((b) * 2 + (h)) * HTB)
#define PG8_SB(b, h) ((4 + (b) * 2 + (h)) * HTB)
#define PG8_STAGE(bufoff, gbase, voff) do { _Pragma("unroll") for (int _i = 0; _i < 2; ++_i) \
        __builtin_amdgcn_global_load_lds((const unsigned*)((const char*)(gbase) + (voff)[_i]), (LAS unsigned*)(lds + (bufoff) + ldsw + _i * 8192), 16, 0, 0); } while (0)
#define PG8_LD8(p) __builtin_shufflevector(*(const LAS v4i*)(p), *(const LAS v4i*)((p) + 1024), 0, 1, 2, 3, 4, 5, 6, 7)
#define PG8_LDA(dst, b, h) do { _Pragma("unroll") for (int m = 0; m < 4; ++m) dst[m] = PG8_LD8(lds + PG8_SA(b, h) + aoff + m * 2048); } while (0)
#define PG8_LDB(dst, b, h) do { _Pragma("unroll") for (int n = 0; n < 2; ++n) dst[n] = PG8_LD8(lds + PG8_SB(b, h) + boff + n * 2048); } while (0)
#define PG8_HALF(X, k) __builtin_bit_cast(bf16x8, __builtin_shufflevector(X, X, 4 * (k), 4 * (k) + 1, 4 * (k) + 2, 4 * (k) + 3))
#define PG8_MMA(ai, bj, At, Bt) do { __builtin_amdgcn_s_setprio(1); _Pragma("unroll") for (int m = 0; m < 4; ++m) _Pragma("unroll") for (int n = 0; n < 2; ++n) { \
        if constexpr (KIND == 1) asm volatile("v_mfma_f32_16x16x128_f8f6f4 %0, %1, %2, %0" : "+v"(acc[ai][bj][m][n]) : "v"(Bt[n]), "v"(At[m]));     \
        else if constexpr (KIND == 2) { acc[ai][bj][m][n] = __builtin_bit_cast(f32x4, __builtin_amdgcn_mfma_i32_16x16x64_i8(__builtin_bit_cast(v4i, PG8_HALF(Bt[n], 0)), __builtin_bit_cast(v4i, PG8_HALF(At[m], 0)), __builtin_bit_cast(v4i, acc[ai][bj][m][n]), 0, 0, 0)); \
               acc[ai][bj][m][n] = __builtin_bit_cast(f32x4, __builtin_amdgcn_mfma_i32_16x16x64_i8(__builtin_bit_cast(v4i, PG8_HALF(Bt[n], 1)), __builtin_bit_cast(v4i, PG8_HALF(At[m], 1)), __builtin_bit_cast(v4i, acc[ai][bj][m][n]), 0, 0, 0)); } \
        else { acc[ai][bj][m][n] = __builtin_amdgcn_mfma_f32_16x16x32_bf16(PG8_HALF(Bt[n], 0), PG8_HALF(At[m], 0), acc[ai][bj][m][n], 0, 0, 0); \
               acc[ai][bj][m][n] = __builtin_amdgcn_mfma_f32_16x16x32_bf16(PG8_HALF(Bt[n], 1), PG8_HALF(At[m], 1), acc[ai][bj][m][n], 0, 0, 0); } } __builtin_amdgcn_s_setprio(0); } while (0)
#define PG8_WAIT_V(n) asm volatile("s_waitcnt vmcnt(" #n ")" ::: "memory")
#define PG8_WAIT_VI(n) asm volatile("s_waitcnt vmcnt(%0)" :: "n"(n) : "memory")
#define PG8_WAIT_L(n) asm volatile("s_waitcnt lgkmcnt(" #n ")" ::: "memory")
#define PG8_BAR __builtin_amdgcn_s_barrier()
#define PG8_SCHED __builtin_amdgcn_sched_barrier(0)
    Unit cur, nxt; int ui = 0;
    if (!S.next(0, cur)) return;
    Acc acc;
#pragma unroll
    for (int a = 0; a < 2; ++a)
#pragma unroll
        for (int b = 0; b < 2; ++b)
#pragma unroll
            for (int m = 0; m < 4; ++m)
#pragma unroll
                for (int n = 0; n < 2; ++n) acc[a][b][m][n] = (f32x4){0.f, 0.f, 0.f, 0.f};
    v8i At[4], B0[2], B1[2];
    const char* cA = S.Aptr(cur); const char* cB = S.Bptr(cur);
    PG8_STAGE(PG8_SB(0, 0), cB, voffB); PG8_STAGE(PG8_SB(0, 1), cB + hstepB, voffB); PG8_STAGE(PG8_SA(0, 0), cA, voffA); PG8_STAGE(PG8_SA(0, 1), cA + hstepA, voffA);
    if (wr == 1) PG8_BAR;
    PG8_WAIT_V(2); PG8_BAR;
    PG8_STAGE(PG8_SB(1, 0), cB + kstep, voffB); PG8_STAGE(PG8_SB(1, 1), cB + hstepB + kstep, voffB); PG8_STAGE(PG8_SA(1, 0), cA + kstep, voffA); PG8_STAGE(PG8_SA(1, 1), cA + kstep + hstepA, voffA);
    PG8_WAIT_V(8); PG8_BAR;
    constexpr int NS = Epi::NSTORES;
    for (;;) {
        const bool has_next = S.next(ui + 1, nxt);
        const char* nA = has_next ? S.Aptr(nxt) : cA; const char* nB = has_next ? S.Bptr(nxt) : cB;
#define PG8_ITER(W1, W2, W3) { const bool last = (t == nt - 2);                                                                                                         \
            const char* a2 = last ? nA : cA + (size_t)(t + 2) * kstep; const char* b2 = last ? nB : cB + (size_t)(t + 2) * kstep;                                        \
            const char* b3 = b2 + kstep; const char* a3 = a2 + kstep;                                                                                                    \
            PG8_LDB(B0, 0, 0); PG8_LDB(B1, 0, 1); PG8_SCHED; PG8_LDA(At, 0, 0);                                                                                          \
            if (t == 0 && ui > 0) PG8_WAIT_VI(NS + W1); else PG8_WAIT_VI(W1); PG8_WAIT_L(0); PG8_BAR; PG8_MMA(0, 0, At, B0); PG8_MMA(0, 1, At, B1); PG8_BAR; PG8_SCHED;                                                   \
            PG8_LDA(At, 0, 1); PG8_STAGE(PG8_SB(0, 0), b2, voffB); PG8_STAGE(PG8_SB(0, 1), b2 + hstepB, voffB);                                                          \
            if (t == 0 && ui > 0) PG8_WAIT_VI(NS + W2); else PG8_WAIT_VI(W2); PG8_WAIT_L(0); PG8_BAR; PG8_MMA(1, 0, At, B0); PG8_MMA(1, 1, At, B1); PG8_BAR; PG8_SCHED;                                                   \
            PG8_LDB(B0, 1, 0); PG8_LDB(B1, 1, 1); PG8_SCHED; PG8_LDA(At, 1, 0); PG8_STAGE(PG8_SA(0, 0), a2, voffA); PG8_STAGE(PG8_SA(0, 1), a2 + hstepA, voffA);         \
            if (t == 0 && ui > 0) PG8_WAIT_VI(NS + W3); else PG8_WAIT_VI(W3); PG8_WAIT_L(0); PG8_BAR; PG8_MMA(0, 0, At, B0); PG8_MMA(0, 1, At, B1); PG8_BAR; PG8_SCHED;                                                   \
            PG8_LDA(At, 1, 1); PG8_STAGE(PG8_SB(1, 0), b3, voffB); PG8_STAGE(PG8_SB(1, 1), b3 + hstepB, voffB);                                                          \
            PG8_WAIT_V(6); PG8_WAIT_L(0); PG8_BAR; PG8_MMA(1, 0, At, B0); PG8_MMA(1, 1, At, B1); PG8_BAR; PG8_SCHED;                                                     \
            PG8_STAGE(PG8_SA(1, 0), a3, voffA); PG8_STAGE(PG8_SA(1, 1), a3 + hstepA, voffA); PG8_SCHED; }
        for (int t = 0; t < nt; t += 2) PG8_ITER(8, 6, 8)
#undef PG8_ITER
        if (wr == 0) PG8_BAR;
        if constexpr (KIND == 1) asm volatile("s_nop 15\n\ts_nop 15" ::: "memory");
        {
            int ln_e; asm volatile("v_mbcnt_lo_u32_b32 %0, -1, 0\n\tv_mbcnt_hi_u32_b32 %0, -1, %0" : "=v"(ln_e));
            E(acc, cur, wr, wc, ln_e & 15, ln_e >> 4); }
        if (!has_next) break;
#pragma unroll
        for (int a = 0; a < 2; ++a)
#pragma unroll
            for (int b = 0; b < 2; ++b)
#pragma unroll
                for (int m = 0; m < 4; ++m)
#pragma unroll
                    for (int n = 0; n < 2; ++n) acc[a][b][m][n] = (f32x4){0.f, 0.f, 0.f, 0.f};
        cur = nxt; cA = nA; cB = nB; ++ui;
        if (wr == 1) PG8_BAR;
    }
    PG8_WAIT_V(0);
    PG8_BAR;
#undef PG8_SA
#undef PG8_SB
#undef PG8_STAGE
#undef PG8_LDA
#undef PG8_LDB
#undef PG8_MMA
#undef PG8_HALF
#undef PG8_LD8
#undef PG8_WAIT_V
#undef PG8_WAIT_VI
#undef PG8_WAIT_L
#undef PG8_BAR
#undef PG8_SCHED
}
}

namespace att {
constexpr int LDP = WIN;
constexpr int SHM_V = 64 * 128 * 2, SHM_K = 64 * 128 * 2;
constexpr int SHM_ATTN = 2 * SHM_V + 2 * SHM_K + 8 * 64 * 4;
#define KSWZ(row, colB) ((row) * 256 + ((colB) ^ (((row) & 7) << 4)))
#define SBAR() __builtin_amdgcn_sched_barrier(0)
__device__ __forceinline__ int crow(int r, int hi) { return (r & 3) + 8 * (r >> 2) + 4 * hi; }
__device__ __forceinline__ int v_st(int k, int c) { const int kk = (k & ~0xC) | ((k & 4) << 1) | ((k & 8) >> 1); return ((kk >> 3) * 4 + (c >> 5)) * 512 + ((kk & 7) * 32 + (c & 31)) * 2; }
__device__ __forceinline__ int v_rd_base(int lane) { return ((lane & 3) << 3) | (((lane >> 2) & 3) << 6) | (((lane >> 4) & 1) << 5) | (((lane >> 5) & 1) << 8); }
constexpr int v_rd_off(int d0, int ks, int half) { return d0 * 512 + ks * 4096 + half * 2048; }
template <int OFF> __device__ __forceinline__ s16x4 tr_read(int vb) {
    s16x4 r; asm volatile("ds_read_b64_tr_b16 %0, %1 offset:%2" : "=&v"(r) : "v"(vb), "i"(OFF) : "memory"); return r;
}
template <int D0> __device__ __forceinline__ void pv_one(f32x16& od, int vb, bf16x8 pa0, bf16x8 pa1, bf16x8 pa2, bf16x8 pa3) {
    const s16x4 l0 = tr_read<v_rd_off(D0, 0, 0)>(vb), h0 = tr_read<v_rd_off(D0, 0, 1)>(vb), l1 = tr_read<v_rd_off(D0, 1, 0)>(vb), h1 = tr_read<v_rd_off(D0, 1, 1)>(vb);
    const s16x4 l2 = tr_read<v_rd_off(D0, 2, 0)>(vb), h2 = tr_read<v_rd_off(D0, 2, 1)>(vb), l3 = tr_read<v_rd_off(D0, 3, 0)>(vb), h3 = tr_read<v_rd_off(D0, 3, 1)>(vb);
    asm volatile("s_waitcnt lgkmcnt(0)" ::: "memory"); SBAR();
#define PK(L, H) (bf16x8){L[0], L[1], L[2], L[3], H[0], H[1], H[2], H[3]}
    od = __builtin_amdgcn_mfma_f32_32x32x16_bf16(pa0, PK(l0, h0), od, 0, 0, 0);
    od = __builtin_amdgcn_mfma_f32_32x32x16_bf16(pa1, PK(l1, h1), od, 0, 0, 0);
    od = __builtin_amdgcn_mfma_f32_32x32x16_bf16(pa2, PK(l2, h2), od, 0, 0, 0);
    od = __builtin_amdgcn_mfma_f32_32x32x16_bf16(pa3, PK(l3, h3), od, 0, 0, 0);
#undef PK
}
__device__ __forceinline__ void pv_d0(f32x16* o, int vb, bf16x8 pa0, bf16x8 pa1, bf16x8 pa2, bf16x8 pa3) {
    pv_one<0>(o[0], vb, pa0, pa1, pa2, pa3); pv_one<1>(o[1], vb, pa0, pa1, pa2, pa3); pv_one<2>(o[2], vb, pa0, pa1, pa2, pa3); pv_one<3>(o[3], vb, pa0, pa1, pa2, pa3);
}
__device__ __forceinline__ void partialSM(f32x16& p0, f32x16& p1, float& m_reg, float& mn, float& alpha, float C, float thr) {
    float pmax = p0[0];
#pragma unroll
    for (int r = 1; r < 16; ++r) pmax = fmaxf(pmax, p0[r]);
#pragma unroll
    for (int r = 0; r < 16; ++r) pmax = fmaxf(pmax, p1[r]);
    { auto rr = __builtin_amdgcn_permlane32_swap(__float_as_uint(pmax), __float_as_uint(pmax), false, false);
      pmax = fmaxf(__uint_as_float(rr[0]), __uint_as_float(rr[1])); }
    if (__builtin_expect(__all(pmax - m_reg <= thr), 1)) { mn = m_reg; alpha = 1.f; }
    else { mn = fmaxf(m_reg, pmax); alpha = __builtin_amdgcn_exp2f((m_reg - mn) * C); m_reg = mn; }
    const float mnC = -mn * C;
#pragma unroll
    for (int r = 0; r < 16; ++r) p0[r] = fmaf(p0[r], C, mnC);
#pragma unroll
    for (int r = 0; r < 16; ++r) p1[r] = fmaf(p1[r], C, mnC);
#pragma unroll
    for (int r = 0; r < 16; ++r) p0[r] = __builtin_amdgcn_exp2f(p0[r]);
}
#define PK4(P, BASE, OUT) do { unsigned a0 = cvt_pk_bf16(P[BASE + 0], P[BASE + 1]), a1 = cvt_pk_bf16(P[BASE + 2], P[BASE + 3]);   \
    unsigned b0 = cvt_pk_bf16(P[BASE + 4], P[BASE + 5]), b1 = cvt_pk_bf16(P[BASE + 6], P[BASE + 7]);                              \
    auto r0 = __builtin_amdgcn_permlane32_swap(a0, b0, false, false); auto r1 = __builtin_amdgcn_permlane32_swap(a1, b1, false, false); \
    u32x4 w = {r0[0], r1[0], r0[1], r1[1]}; OUT = __builtin_bit_cast(bf16x8, w); } while (0)
__device__ __forceinline__ void finishSM(f32x16& p0, f32x16& p1, float alpha, float& l_reg, bf16x8& pa0, bf16x8& pa1, bf16x8& pa2, bf16x8& pa3) {
#pragma unroll
    for (int r = 0; r < 16; ++r) p1[r] = __builtin_amdgcn_exp2f(p1[r]);
    float ps = 0;
#pragma unroll
    for (int r = 0; r < 16; ++r) ps += p0[r];
#pragma unroll
    for (int r = 0; r < 16; ++r) ps += p1[r];
    { auto rr = __builtin_amdgcn_permlane32_swap(__float_as_uint(ps), __float_as_uint(ps), false, false);
      ps = __uint_as_float(rr[0]) + __uint_as_float(rr[1]); }
    l_reg = l_reg * alpha + ps;
    PK4(p0, 0, pa0); PK4(p0, 8, pa1); PK4(p1, 0, pa2); PK4(p1, 8, pa3);
}
__device__ __forceinline__ void packP(f32x16& p0, f32x16& p1, bf16x8& pa0, bf16x8& pa1, bf16x8& pa2, bf16x8& pa3) {
    PK4(p0, 0, pa0); PK4(p0, 8, pa1); PK4(p1, 0, pa2); PK4(p1, 8, pa3);
}
struct RetP { float lf2, lb2, lrs; int qs0, latq; };
template <bool EXTRA> __device__ __forceinline__ void retP(f32x16& p0, f32x16& p1, int qs, int ks0, int hi, const RetP& rp) {
    const float dbase = (float)(qs - ks0 - 4 * hi), ebase = (float)(TPB - qs + ks0 + 4 * hi), nlb2 = -rp.lb2;
#pragma unroll
    for (int r = 0; r < 16; ++r) {
        const float cr = (float)((r & 3) + 8 * (r >> 2));
        const float d0 = dbase - cr, d1 = d0 - 32.f;
        float f0 = __builtin_amdgcn_exp2f(fmaf(d0 > 0.f ? rp.lf2 : nlb2, d0, rp.lrs)), f1 = __builtin_amdgcn_exp2f(fmaf(d1 > 0.f ? rp.lf2 : nlb2, d1, rp.lrs));
        f0 = (d0 == 0.f) ? f0 + f0 : f0; f1 = (d1 == 0.f) ? f1 + f1 : f1;
        if (EXTRA) { f0 += __builtin_amdgcn_exp2f(fmaf(rp.lb2, ebase + cr, rp.lrs)); f1 += __builtin_amdgcn_exp2f(fmaf(rp.lb2, ebase + cr + 32.f, rp.lrs)); }
        p0[r] *= f0; p1[r] *= f1;
        if ((r & 3) == 3) __builtin_amdgcn_sched_barrier(0);
    }
}
template <int KIND> __device__ __forceinline__ void retT(f32x16& p0, f32x16& p1, float Fl, float Bl, float dbase, const LAS float* tab) {
#pragma unroll
    for (int g = 0; g < 4; ++g) {
        f32x4 tf0 = {}, tf1 = {}, tb0 = {}, tb1 = {};
        if (KIND != 2) { tf0 = *(const LAS f32x4*)(tab + 8 * g); tf1 = *(const LAS f32x4*)(tab + 32 + 8 * g); }
        if (KIND != 1) { tb0 = *(const LAS f32x4*)(tab + 64 + 8 * g); tb1 = *(const LAS f32x4*)(tab + 96 + 8 * g); }
#pragma unroll
        for (int e = 0; e < 4; ++e) { const int r = 4 * g + e; float w0, w1;
            if (KIND == 1) { w0 = Fl * tf0[e]; w1 = Fl * tf1[e]; }
            else if (KIND == 2) { w0 = Bl * tb0[e]; w1 = Bl * tb1[e]; }
            else if (KIND == 3) { w0 = fmaf(Bl, tb0[e], Fl * tf0[e]); w1 = fmaf(Bl, tb1[e], Fl * tf1[e]); }
            else { const float c0 = (float)(8 * g + e), c1 = c0 + 32.f; const float a0 = Fl * tf0[e], b0 = Bl * tb0[e], a1 = Fl * tf1[e], b1 = Bl * tb1[e];
                w0 = (c0 == dbase) ? a0 + b0 : fminf(a0, b0); w1 = (c1 == dbase) ? a1 + b1 : fminf(a1, b1); }
            p0[r] *= w0; p1[r] *= w1; }
    }
}
__device__ __forceinline__ int ret_class(int tile, int latq, int tq0) { return !latq ? 0 : (tile >= 4 && tile < tq0) ? 1 : (tile >= tq0 + 4) ? 2 : 0; }
__device__ __forceinline__ bf16x8 scale8(bf16x8 v, float f) { float x[8]; unpack8(__builtin_bit_cast(u32x4, v), x);
#pragma unroll
    for (int e = 0; e < 8; ++e) x[e] *= f;
    return __builtin_bit_cast(bf16x8, pack8(x)); }
template <int ND0> __device__ __forceinline__ void qkt(f32x16& p0, f32x16& p1, const LAS char* Ks, const bf16x8* qr, int r32, int hi, int kcolB) {
    p0 = f32x16{}; p1 = f32x16{};
#pragma unroll
    for (int d0 = 0; d0 < ND0; ++d0) { const int cb = (d0 * 16 + hi * 8) * 2;
        const bf16x8 b0 = *(const LAS bf16x8*)(Ks + KSWZ(r32, cb) + kcolB);
        const bf16x8 b1 = *(const LAS bf16x8*)(Ks + KSWZ(32 + r32, cb) + kcolB);
        p0 = __builtin_amdgcn_mfma_f32_32x32x16_bf16(b0, qr[d0], p0, 0, 0, 0);
        p1 = __builtin_amdgcn_mfma_f32_32x32x16_bf16(b1, qr[d0], p1, 0, 0, 0); }
}
struct QFix { const float* g; const float* cs; const float* sn; int t0; };
struct Fuse { int role; float lam, post; const float* sg; const bf16* bg; };
constexpr int STASH_OFF = 69632;
static_assert(SHM_ATTN + 512 <= STASH_OFF && STASH_OFF + 8 * 8192 <= MISC_OFF, "attention LDS image / pair stash / MISC overlap");
template <int MODE, int SDEPTH>
__device__ __forceinline__ void attn_unit(const bf16* __restrict__ Qb, const bf16* __restrict__ Kh, const bf16* __restrict__ Vh, bf16* __restrict__ Ob, int ldo, int seq,
                                          float scale, int kcolB, const RetP rp, LAS char* lds, const int tid, const QFix qf, const Fuse fz) {
    constexpr int ND0 = (MODE == 1) ? 4 : 8;
    const int wid = tid >> 6, lane = tid & 63, r32 = lane & 31, hi = lane >> 5;
    LAS char* V_lds = lds; LAS char* K_lds = lds + 2 * SHM_V;
    LAS float* ws = (LAS float*)(lds + 2 * SHM_V + 2 * SHM_K) + wid * 64; LAS float* li_l = ws; LAS float* al_l = ws + 32;
    const float C = scale * LOG2E, thr = 8.f / scale;
    float m_reg = -1e30f, l_reg = 0; f32x16 o[4] = {}; bf16x8 qr[ND0];
    const bf16* Qw = Qb + (long)(wid * 32 + r32) * LDP + hi * 8;
#pragma unroll
    for (int d0 = 0; d0 < ND0; ++d0) qr[d0] = *(const bf16x8*)(Qw + d0 * 16);
    {
        constexpr int NH = ND0 / 2; float xq[ND0][8];
#pragma unroll
        for (int d0 = 0; d0 < ND0; ++d0) unpack8(__builtin_bit_cast(u32x4, qr[d0]), xq[d0]);
        if (MODE == 0) { float ss = 0.f;
#pragma unroll
            for (int d0 = 0; d0 < ND0; ++d0)
#pragma unroll
                for (int e = 0; e < 8; ++e) ss += xq[d0][e] * xq[d0][e];
            ss += shflx(ss, 32, lane);
            const float rstd = rsqrtf(ss * (1.f / 128.f) + EPS);
#pragma unroll
            for (int d0 = 0; d0 < ND0; ++d0) { const f32x4 g0 = *(const f32x4*)(qf.g + d0 * 16 + hi * 8), g1 = *(const f32x4*)(qf.g + d0 * 16 + hi * 8 + 4);
#pragma unroll
                for (int e = 0; e < 4; ++e) { xq[d0][e] *= rstd * g0[e]; xq[d0][4 + e] *= rstd * g1[e]; } } }
        if (qf.t0 >= 0) { const int t = qf.t0 + wid * 32 + r32; const float* cs = qf.cs + (size_t)t * (8 * ND0) + hi * 8; const float* sn = qf.sn + (size_t)t * (8 * ND0) + hi * 8;
#pragma unroll
            for (int d0 = 0; d0 < NH; ++d0) { const f32x4 c0 = *(const f32x4*)(cs + d0 * 16), c1 = *(const f32x4*)(cs + d0 * 16 + 4), s0 = *(const f32x4*)(sn + d0 * 16), s1 = *(const f32x4*)(sn + d0 * 16 + 4);
#pragma unroll
                for (int e = 0; e < 4; ++e) { const float a0 = xq[d0][e], b0 = xq[d0 + NH][e], a1 = xq[d0][4 + e], b1 = xq[d0 + NH][4 + e];
                    xq[d0][e] = a0 * c0[e] - b0 * s0[e]; xq[d0 + NH][e] = b0 * c0[e] + a0 * s0[e]; xq[d0][4 + e] = a1 * c1[e] - b1 * s1[e]; xq[d0 + NH][4 + e] = b1 * c1[e] + a1 * s1[e]; } } }
        if (MODE == 0 || qf.t0 >= 0) {
#pragma unroll
            for (int d0 = 0; d0 < ND0; ++d0) qr[d0] = __builtin_bit_cast(bf16x8, pack8(xq[d0])); }
    }
    const int qs = rp.qs0 + wid * 32 + r32;
    const int qw0 = rp.qs0 + __builtin_amdgcn_readfirstlane(wid) * 32;
    LAS float* rtab = (LAS float*)(lds + 2 * SHM_V + 2 * SHM_K + 2048);
    if (MODE == 2 && tid < 128) rtab[tid] = __builtin_amdgcn_exp2f((tid < 64 ? -rp.lf2 : rp.lb2) * (float)(tid & 63));
    const int sr = tid >> 4, sc = (tid & 15) * 8, vst0 = v_st(sr, sc), vst1 = v_st(32 + sr, sc);
    const int vb0 = (int)(unsigned)(uintptr_t)V_lds + v_rd_base(lane);
    const int tq0 = rp.qs0 >> 6;
    float vf0 = 1.f, vf1 = 1.f, vb0f = 1.f, vb1f = 1.f;
    if (MODE == 2) { vf0 = __builtin_amdgcn_exp2f(rp.lf2 * (float)(63 - sr)); vf1 = __builtin_amdgcn_exp2f(rp.lf2 * (float)(31 - sr)); vb0f = __builtin_amdgcn_exp2f(rp.lb2 * (float)sr); vb1f = __builtin_amdgcn_exp2f(rp.lb2 * (float)(32 + sr)); }
    struct { bf16x8 vs0, vs1, ks0, ks1; } sr_[SDEPTH];
#define SLOAD(i, k0) do { sr_[i].vs0 = *(const bf16x8*)(&Vh[(long)((k0) + sr) * LDP + sc]); sr_[i].vs1 = *(const bf16x8*)(&Vh[(long)((k0) + 32 + sr) * LDP + sc]); \
    sr_[i].ks0 = *(const bf16x8*)(&Kh[(long)((k0) + sr) * LDP + sc]); sr_[i].ks1 = *(const bf16x8*)(&Kh[(long)((k0) + 32 + sr) * LDP + sc]); } while (0)
#define SWRITE(b, i, TILE) do { bf16x8 v0_ = sr_[i].vs0, v1_ = sr_[i].vs1; \
    if (MODE == 2) { const int cls_ = ret_class(TILE, rp.latq, tq0); if (cls_ == 1) { v0_ = scale8(v0_, vf0); v1_ = scale8(v1_, vf1); } else if (cls_ == 2) { v0_ = scale8(v0_, vb0f); v1_ = scale8(v1_, vb1f); } } \
    *(LAS bf16x8*)(V_lds + (b) * SHM_V + vst0) = v0_;          \
    *(LAS bf16x8*)(V_lds + (b) * SHM_V + vst1) = v1_; const int kc = sc * 2;               \
    *(LAS bf16x8*)(K_lds + (b) * SHM_K + KSWZ(sr, kc)) = sr_[i].ks0;                       \
    *(LAS bf16x8*)(K_lds + (b) * SHM_K + KSWZ(32 + sr, kc)) = sr_[i].ks1; } while (0)
#define SWAIT() do { if (SDEPTH == 2) asm volatile("s_waitcnt vmcnt(4)" ::: "memory"); else asm volatile("s_waitcnt vmcnt(0)" ::: "memory"); } while (0)
#define RESC(a) do { if (MODE != 2) { if (__any((a) < 1.f)) { if (hi == 0) al_l[r32] = (a); asm volatile("s_waitcnt lgkmcnt(0)" ::: "memory"); \
    _Pragma("unroll") for (int d = 0; d < 4; ++d) _Pragma("unroll") for (int r = 0; r < 16; ++r) o[d][r] *= al_l[crow(r, hi)]; } } } while (0)
#define PART(P0, P1, MN, AL, TILE) do { if (MODE == 2) { const int cls_ = ret_class(TILE, rp.latq, tq0); \
        if (cls_ == 0) { const float db_ = (float)(qs - (TILE) * 64 - 4 * hi); const int kq_ = (TILE) * 64 - qw0; const float Ff_ = __builtin_amdgcn_exp2f(fmaf(rp.lf2, db_, rp.lrs)); \
            if (rp.latq && (TILE) < 4) retT<3>(P0, P1, Ff_, __builtin_amdgcn_exp2f(fmaf(rp.lb2, (float)TPB - db_, rp.lrs)), db_, rtab); \
            else if (kq_ + 63 < 0) retT<1>(P0, P1, Ff_, 0.f, db_, rtab); \
            else if (kq_ > 31) retT<2>(P0, P1, 0.f, __builtin_amdgcn_exp2f(fmaf(-rp.lb2, db_, rp.lrs)), db_, rtab); \
            else retT<0>(P0, P1, Ff_, __builtin_amdgcn_exp2f(fmaf(-rp.lb2, db_, rp.lrs)), db_, rtab); } \
        else { const float rs_ = __builtin_amdgcn_exp2f(cls_ == 1 ? fmaf(rp.lf2, (float)(qs - (TILE) * 64 - 63), rp.lrs) : fmaf(rp.lb2, (float)((TILE) * 64 - qs), rp.lrs)); \
            _Pragma("unroll") for (int r_ = 0; r_ < 16; ++r_) { P0[r_] *= rs_; P1[r_] *= rs_; } } } \
    else partialSM(P0, P1, m_reg, MN, AL, C, thr); } while (0)
#define FIN(P0, P1, AL) do { if (MODE == 2) packP(P0, P1, pa0, pa1, pa2, pa3); else finishSM(P0, P1, AL, l_reg, pa0, pa1, pa2, pa3); } while (0)
    if (__builtin_amdgcn_readfirstlane(wid) >= 4) __builtin_amdgcn_s_setprio(1);
    f32x16 pA0, pA1, pB0, pB1; float mnA = 0.f, mnB = 0.f, alA = 1.f, alB = 1.f; bf16x8 pa0, pa1, pa2, pa3; const int NT = seq / 64;
    constexpr int SE = 0, SO = SDEPTH - 1;
    SLOAD(SE, 0); asm volatile("s_waitcnt vmcnt(0)" ::: "memory"); SWRITE(0, SE, 0); __syncthreads();
    qkt<ND0>(pA0, pA1, K_lds, qr, r32, hi, kcolB); PART(pA0, pA1, mnA, alA, 0);
    SLOAD(SO, 64); if (SDEPTH == 2) { if (2 < NT) SLOAD(SE, 128); }
    SWAIT(); SWRITE(1, SO, 1); __syncthreads();
    for (int j = 1; j + 1 < NT; j += 2) {
        SBAR(); qkt<ND0>(pB0, pB1, K_lds + SHM_K, qr, r32, hi, kcolB);
        FIN(pA0, pA1, alA); SBAR();
        SLOAD(SO, (j + SDEPTH) * 64); SBAR();
        pv_d0(o, vb0, pa0, pa1, pa2, pa3); PART(pB0, pB1, mnB, alB, j);
        __syncthreads(); SWAIT(); SWRITE(0, SE, j + 1);
        RESC(alB); __syncthreads();
        SBAR(); qkt<ND0>(pA0, pA1, K_lds, qr, r32, hi, kcolB);
        FIN(pB0, pB1, alB); SBAR();
        if (SDEPTH == 1 || j + 3 < NT) SLOAD(SE, (j + 1 + SDEPTH) * 64); SBAR();
        pv_d0(o, vb0 + SHM_V, pa0, pa1, pa2, pa3); PART(pA0, pA1, mnA, alA, j + 1);
        __syncthreads(); SWAIT(); SWRITE(1, SO, j + 2);
        RESC(alA); __syncthreads();
    }
    SBAR(); qkt<ND0>(pB0, pB1, K_lds + SHM_K, qr, r32, hi, kcolB);
    FIN(pA0, pA1, alA); SBAR();
    pv_d0(o, vb0, pa0, pa1, pa2, pa3); PART(pB0, pB1, mnB, alB, NT - 1);
    __syncthreads(); RESC(alB);
    FIN(pB0, pB1, alB); SBAR();
    pv_d0(o, vb0 + SHM_V, pa0, pa1, pa2, pa3);
    __builtin_amdgcn_s_setprio(0);
    float rli[16];
    if (MODE != 2) { if (hi == 0) li_l[r32] = l_reg; asm volatile("s_waitcnt lgkmcnt(0)" ::: "memory");
#pragma unroll
        for (int r = 0; r < 16; ++r) rli[r] = __builtin_amdgcn_rcpf(li_l[crow(r, hi)]); }
    else {
#pragma unroll
        for (int r = 0; r < 16; ++r) rli[r] = 1.f; }
    bf16* Ow = Ob + (long)(wid * 32) * ldo;
    if (MODE == 0 || fz.role == 0) {
#pragma unroll
        for (int r = 0; r < 16; ++r) { const int orow = crow(r, hi);
#pragma unroll
            for (int d0 = 0; d0 < 4; ++d0) Ow[(long)orow * ldo + d0 * 32 + r32] = (bf16)f2bf(o[d0][r] * rli[r]); }
    } else {
        int ln2 = lane; asm volatile("" : "+v"(ln2));
        LAS u32x4* st = (LAS u32x4*)(lds + STASH_OFF + wid * 8192) + ln2;
        if (fz.role == 1) {
#pragma unroll
            for (int i = 0; i < 8; ++i) { const int r0 = 2 * i, r1 = 2 * i + 1; u32x4 w;
                w.x = cvt_pk_bf16(o[0][r0] * rli[r0], o[1][r0] * rli[r0]); w.y = cvt_pk_bf16(o[2][r0] * rli[r0], o[3][r0] * rli[r0]);
                w.z = cvt_pk_bf16(o[0][r1] * rli[r1], o[1][r1] * rli[r1]); w.w = cvt_pk_bf16(o[2][r1] * rli[r1], o[3][r1] * rli[r1]);
                st[i * 64] = w; }
        } else if (MODE == 1) {
            float ssr[16];
#pragma unroll
            for (int i = 0; i < 8; ++i) { const u32x4 w = st[i * 64];
#pragma unroll
                for (int rr = 0; rr < 2; ++rr) { const int r = 2 * i + rr; const unsigned ua = rr ? w.z : w.x, ub = rr ? w.w : w.y; const float sc2 = fz.lam * rli[r];
                    o[0][r] = bflo(ua) - sc2 * o[0][r]; o[1][r] = bfhi(ua) - sc2 * o[1][r]; o[2][r] = bflo(ub) - sc2 * o[2][r]; o[3][r] = bfhi(ub) - sc2 * o[3][r];
                    ssr[r] = o[0][r] * o[0][r] + o[1][r] * o[1][r] + o[2][r] * o[2][r] + o[3][r] * o[3][r]; } }
#pragma unroll
            for (int r = 0; r < 16; ++r) {
#pragma unroll
                for (int x = 1; x < 32; x <<= 1) ssr[r] += shflx(ssr[r], x, lane); }
            const float sg0 = fz.sg[r32], sg1 = fz.sg[32 + r32], sg2 = fz.sg[64 + r32], sg3 = fz.sg[96 + r32];
#pragma unroll
            for (int r = 0; r < 16; ++r) { const int orow = crow(r, hi); const float rstd = rsqrtf(ssr[r] * (1.f / 128.f) + EPS) * fz.post; bf16* op = Ow + (long)orow * ldo + r32;
                op[0] = (bf16)f2bf(o[0][r] * rstd * sg0); op[32] = (bf16)f2bf(o[1][r] * rstd * sg1); op[64] = (bf16)f2bf(o[2][r] * rstd * sg2); op[96] = (bf16)f2bf(o[3][r] * rstd * sg3); }
        } else {
            float mu[16], rs[16];
#pragma unroll
            for (int i = 0; i < 8; ++i) { const u32x4 w = st[i * 64];
#pragma unroll
                for (int rr = 0; rr < 2; ++rr) { const int r = 2 * i + rr; const unsigned ua = rr ? w.z : w.x, ub = rr ? w.w : w.y;
                    mu[r] = (bflo(ua) + bfhi(ua)) + (bflo(ub) + bfhi(ub)) + (o[0][r] + o[1][r]) + (o[2][r] + o[3][r]); } }
#pragma unroll
            for (int r = 0; r < 16; ++r) {
#pragma unroll
                for (int x = 1; x < 32; x <<= 1) mu[r] += shflx(mu[r], x, lane);
                mu[r] *= (1.f / 256.f); }
            asm volatile("" ::: "memory");
#pragma unroll
            for (int i = 0; i < 8; ++i) { const u32x4 w = st[i * 64];
#pragma unroll
                for (int rr = 0; rr < 2; ++rr) { const int r = 2 * i + rr; const unsigned ua = rr ? w.z : w.x, ub = rr ? w.w : w.y; const float m_ = mu[r];
                    const float a0 = bflo(ua) - m_, a1 = bfhi(ua) - m_, a2 = bflo(ub) - m_, a3 = bfhi(ub) - m_, b0 = o[0][r] - m_, b1 = o[1][r] - m_, b2 = o[2][r] - m_, b3 = o[3][r] - m_;
                    rs[r] = (a0 * a0 + a1 * a1) + (a2 * a2 + a3 * a3) + (b0 * b0 + b1 * b1) + (b2 * b2 + b3 * b3); } }
#pragma unroll
            for (int r = 0; r < 16; ++r) {
#pragma unroll
                for (int x = 1; x < 32; x <<= 1) rs[r] += shflx(rs[r], x, lane);
                rs[r] = rsqrtf(rs[r] * (1.f / 256.f) + GN_EPS); }
            const bf16* gw_ = fz.bg + (long)(wid * 32) * LDP + r32;
            asm volatile("" ::: "memory");
#pragma unroll
            for (int i = 0; i < 8; ++i) { const u32x4 w = st[i * 64]; SBAR();
#pragma unroll
                for (int rr = 0; rr < 2; ++rr) { const int r = 2 * i + rr; const unsigned ua = rr ? w.z : w.x, ub = rr ? w.w : w.y; const float m_ = mu[r], q_ = rs[r];
                    const int orow = crow(r, hi); const bf16* gp = gw_ + (long)orow * LDP; bf16* op = Ow + (long)orow * ldo + r32;
                    const float y0[4] = {bflo(ua), bfhi(ua), bflo(ub), bfhi(ub)};
#pragma unroll
                    for (int d0 = 0; d0 < 4; ++d0) { const float g0 = bflo((unsigned)gp[d0 * 32]), g1 = bflo((unsigned)gp[128 + d0 * 32]);
                        op[d0 * 32] = (bf16)f2bf((y0[d0] - m_) * q_ * g0 * sigmoidf_(g0)); op[128 + d0 * 32] = (bf16)f2bf((o[d0][r] - m_) * q_ * g1 * sigmoidf_(g1)); } } }
        }
    }
    __syncthreads();
#undef SLOAD
#undef SWRITE
#undef SWAIT
#undef RESC
#undef PART
#undef FIN
}
}

struct Args {
    const float* x; const float* c; const float* ctx; const float* c_ctx; const float* w_mod; const float* b_mod; const float* norm_g; const float* w_in;
    const float* qk_g; const float* dlam; const float* subln; const float* rdecay; const float* w_branch; const float* w_bgate; const float* w_out;
    const float* ffn_w_in; const float* ffn_w_out; const float* moe_router; const float* moe_w_in; const float* moe_w_out;
    float* out; unsigned char* ws; int ph_lo, ph_hi;
};

__device__ __forceinline__ int map_row(int n, int N, int map) {
    if (map == 1) { const int Nh = N >> 1, h = n / Nh, c = n - h * Nh; return ((c >> 7) << 8) + (h << 7) + (c & 127); }
    if (map == 2) { const int i = n >> 11, c = n & 2047; return i < 2 ? ((c >> 7) << 8) + (i << 7) + (c & 127) : 4096 + c; }
    return n;
}
constexpr float W8SCALE = 64.f;
__device__ __forceinline__ void tr_load(const float* W, int N, int item, int lane, f32x4 (&v)[16]) {
    const int nblk = N >> 6, kb = item / nblk, nb = item - kb * nblk, k0 = kb << 6, n0 = nb << 6;
    const float* src = W + (size_t)(k0 + (lane >> 4)) * N + n0 + ((lane & 15) << 2);
#pragma unroll
    for (int i = 0; i < 16; ++i) v[i] = *(const f32x4*)(src + (size_t)(4 * i) * N);
}
template <int QK> __device__ __forceinline__ void tr_store(const f32x4 (&v)[16], int K, int N, void* WTv, int map, LAS float* scr, int item, int lane, const unsigned* colmax, float* swc) {
    const int nblk = N >> 6, kb = item / nblk, nb = item - kb * nblk, k0 = kb << 6, n0 = nb << 6;
#pragma unroll
    for (int i = 0; i < 16; ++i) { LAS float* d = scr + (4 * i + (lane >> 4)) * 65 + ((lane & 15) << 2); d[0] = v[i][0]; d[1] = v[i][1]; d[2] = v[i][2]; d[3] = v[i][3]; }
    LDS_WAIT(); asm volatile("" ::: "memory");
    const int c = lane & 7, db = map_row(n0, N, map);
#pragma unroll
    for (int j = 0; j < 8; ++j) { const int n = (lane >> 3) + 8 * j; const LAS float* s = scr + (8 * c) * 65 + n;
        if constexpr (QK == 1) { float v8[8];
#pragma unroll
            for (int e = 0; e < 8; ++e) v8[e] = s[e * 65] * W8SCALE;
            *(u32x2*)((unsigned char*)WTv + (size_t)(db + n) * K + k0 + 8 * c) = pack8_fp8(v8); }
        else if constexpr (QK == 2) { float v8[8]; const float cm = __uint_as_float(colmax[n0 + n]), inv = cm > 0.f ? 127.f / cm : 0.f;
#pragma unroll
            for (int e = 0; e < 8; ++e) v8[e] = s[e * 65] * inv;
            *(u32x2*)((unsigned char*)WTv + (size_t)(db + n) * K + k0 + 8 * c) = pack8_i8(v8);
            if (kb == 0 && c == 0) swc[db + n] = cm * (1.f / 127.f); }
        else { u32x4 o; o.x = pk2(s[0 * 65], s[1 * 65]); o.y = pk2(s[2 * 65], s[3 * 65]); o.z = pk2(s[4 * 65], s[5 * 65]); o.w = pk2(s[6 * 65], s[7 * 65]);
            *(u32x4*)((bf16*)WTv + (size_t)(db + n) * K + k0 + 8 * c) = o; } }
    LDS_WAIT(); asm volatile("" ::: "memory");
}
template <int QK> __device__ __forceinline__ void transpose_run(const float* W, int K, int N, void* WTv, int map, LAS float* scr, int it, int ni, int stride, int lane, const unsigned* colmax = nullptr, float* swc = nullptr) {
    if (it >= ni) return;
    f32x4 va[16], vb[16];
    tr_load(W, N, it, lane, va);
    for (;;) {
        const int nx = it + stride; const bool has = nx < ni;
        if (has) tr_load(W, N, nx, lane, vb);
        tr_store<QK>(va, K, N, WTv, map, scr, it, lane, colmax, swc);
        if (!has) break;
#pragma unroll
        for (int i = 0; i < 16; ++i) va[i] = vb[i];
        it = nx;
    }
}
struct MatDesc { const float* W; void* WT; int K, N, map; };
constexpr int NMAT = 30;
__device__ __forceinline__ int mat_items(int id) {
    if (id < 2) return (2048 / 64) * (WIN / 64);
    if (id < 8) return (1024 / 64) * (2048 / 64);
    if (id < 10) return (2048 / 64) * (6144 / 64);
    if (id < 12) return (2048 / 64) * (2048 / 64);
    if (id == 12) return (2048 / 64) * (11264 / 64);
    if (id == 13) return (FF / 64) * (2048 / 64);
    if (id < 22) return (2048 / 64) * (11264 / 64);
    return (FF / 64) * (2048 / 64);
}
template <class AT> __device__ __forceinline__ void mat_desc(AT& a, int id, MatDesc& d) {
    unsigned char* ws = as_global(a.ws);
    if (id < 2) { d.W = as_global(a.w_in) + (size_t)id * 2048 * WIN; d.WT = (bf16*)(ws + WS_WIN) + (size_t)id * WIN * 2048; d.K = 2048; d.N = WIN; d.map = 0; }
    else if (id < 8) { const int j = id - 2; d.W = as_global(a.w_branch) + (size_t)j * 1024 * 2048; d.WT = (bf16*)(ws + WS_WB) + (size_t)j * 2048 * 1024; d.K = 1024; d.N = 2048; d.map = 0; }
    else if (id < 10) { const int j = id - 8; d.W = as_global(a.w_bgate) + (size_t)j * 2048 * 6144; d.WT = (bf16*)(ws + WS_WG) + (size_t)j * 6144 * 2048; d.K = 2048; d.N = 6144; d.map = 2; }
    else if (id < 12) { const int j = id - 10; d.W = as_global(a.w_out) + (size_t)j * 2048 * 2048; d.WT = (bf16*)(ws + WS_WO) + (size_t)j * 2048 * 2048; d.K = 2048; d.N = 2048; d.map = 0; }
    else if (id == 12) { d.W = as_global(a.ffn_w_in); d.WT = ws + WS_WF1; d.K = 2048; d.N = 2 * FF; d.map = 1; }
    else if (id == 13) { d.W = as_global(a.ffn_w_out); d.WT = ws + WS_WF2; d.K = FF; d.N = 2048; d.map = 0; }
    else if (id < 22) { const int j = id - 14; d.W = as_global(a.moe_w_in) + (size_t)j * 2048 * 2 * FF; d.WT = ws + WS_WM1 + (size_t)j * 2 * FF * 2048; d.K = 2048; d.N = 2 * FF; d.map = 1; }
    else { const int j = id - 22; d.W = as_global(a.moe_w_out) + (size_t)j * FF * 2048; d.WT = ws + WS_WM2 + (size_t)j * 2048 * FF; d.K = FF; d.N = 2048; d.map = 0; }
}

constexpr bool q_enabled(int q) { return q == 0 || ((q == 1 || q == 2) && I8_GATES) || (q == 3 && (I8_P1 & 1)) || (q == 4 && (I8_P1 & 2)); }
struct QMat { const float* W; unsigned char* WT; int N, map; };
template <class AT> __device__ __forceinline__ QMat qmat(AT& a, unsigned char* ws, int q) {
    if (q == 0) return QMat{as_global(a.ffn_w_in), ws + WS_WF1, 2 * FF, 1};
    if (q <= 2) return QMat{as_global(a.w_bgate) + (size_t)(q - 1) * 2048 * 6144, ws + WS_WG + (size_t)(q - 1) * 6144 * 2048, 6144, 2};
    return QMat{as_global(a.w_in) + (size_t)(q - 3) * 2048 * WIN, ws + WS_WIN + (size_t)(q - 3) * WIN * 2048, WIN, 0};
}
constexpr int NWAVES = 8;
typedef __attribute__((address_space(4))) const Args CArgs;
__device__ __forceinline__ CArgs* phase_args() { CArgs* p = (CArgs*)__builtin_amdgcn_kernarg_segment_ptr(); asm volatile("" : "+s"(p)); return p; }
__device__ __forceinline__ int lat_row(int it) { return it + ((it >> 11) + 1) * CTXL; }

__device__ __forceinline__ void row_update(const void* xin, bool xin_f32, void* xout, bool xout_f32, float (&yv)[32], float rstd_y, const float* mg, const float* gg,
                                           bool do_norm, const float* ng, const float* nsc, const float* nsh, bf16* hout, unsigned char* hout8, float* sarow, int lane) {
    float xv[32]; float sx = 0.f;
#pragma unroll
    for (int j = 0; j < 4; ++j) { const int c0 = 512 * j + 8 * lane;
        f32x4 v0, v1;
        if (xin_f32) { v0 = *(const f32x4*)((const float*)xin + c0); v1 = *(const f32x4*)((const float*)xin + c0 + 4); }
        else { float t[8]; unpack8(*(const u32x4*)((const bf16*)xin + c0), t); v0 = (f32x4){t[0], t[1], t[2], t[3]}; v1 = (f32x4){t[4], t[5], t[6], t[7]}; }
        const f32x4 m0 = *(const f32x4*)(mg + c0), m1 = *(const f32x4*)(mg + c0 + 4), g0 = *(const f32x4*)(gg + c0), g1 = *(const f32x4*)(gg + c0 + 4);
#pragma unroll
        for (int e = 0; e < 4; ++e) { v0[e] += m0[e] * g0[e] * yv[8 * j + e] * rstd_y; v1[e] += m1[e] * g1[e] * yv[8 * j + 4 + e] * rstd_y; xv[8 * j + e] = v0[e]; xv[8 * j + 4 + e] = v1[e]; sx += v0[e] * v0[e] + v1[e] * v1[e]; }
        if (xout_f32) { *(f32x4*)((float*)xout + c0) = v0; *(f32x4*)((float*)xout + c0 + 4) = v1; }
        else { const float t[8] = {v0[0], v0[1], v0[2], v0[3], v1[0], v1[1], v1[2], v1[3]}; *(u32x4*)((bf16*)xout + c0) = pack8(t); } }
    if (do_norm) {
        const float rstd_x = rsqrtf(wave_sum(sx, lane) * (1.f / D) + EPS);
#pragma unroll
        for (int j = 0; j < 4; ++j) { const int c0 = 512 * j + 8 * lane; float o[8];
            const f32x4 n0 = *(const f32x4*)(ng + c0), n1 = *(const f32x4*)(ng + c0 + 4), s0 = *(const f32x4*)(nsc + c0), s1 = *(const f32x4*)(nsc + c0 + 4), h0 = *(const f32x4*)(nsh + c0), h1 = *(const f32x4*)(nsh + c0 + 4);
#pragma unroll
            for (int e = 0; e < 4; ++e) { o[e] = xv[8 * j + e] * rstd_x * n0[e] * (1.f + s0[e]) + h0[e]; o[4 + e] = xv[8 * j + 4 + e] * rstd_x * n1[e] * (1.f + s1[e]) + h1[e]; }
#pragma unroll
            for (int e = 0; e < 8; ++e) yv[8 * j + e] = o[e];
            if (hout) *(u32x4*)(hout + c0) = pack8(o);
            if (hout8 && !sarow) *(u32x2*)(hout8 + c0) = pack8_fp8(o); }
        if (hout8 && sarow) {
            float am = 0.f;
#pragma unroll
            for (int e = 0; e < 32; ++e) am = fmaxf(am, fabsf(yv[e]));
#pragma unroll
            for (int o_ = 1; o_ < 64; o_ <<= 1) am = fmaxf(am, shflx(am, o_, lane));
            const float inv = am > 0.f ? 127.f / am : 0.f;
#pragma unroll
            for (int j = 0; j < 4; ++j) { float q[8];
#pragma unroll
                for (int e = 0; e < 8; ++e) q[e] = yv[8 * j + e] * inv;
                *(u32x2*)(hout8 + 512 * j + 8 * lane) = pack8_i8(q); }
            if (lane == 0) *sarow = am * (1.f / 127.f);
        }
    }
}

__global__ void __launch_bounds__(NWAVES * 64, 2) fwd_kernel(Args a_unused) {
    extern __shared__ __attribute__((aligned(16))) unsigned char lds_raw[];
    LAS unsigned char* lds = (LAS unsigned char*)lds_raw;
    volatile LAS unsigned* MISC = (volatile LAS unsigned*)(lds + MISC_OFF);
    const int tid = threadIdx.x, lane = tid & 63, wave = __builtin_amdgcn_readfirstlane(tid >> 6);
    const int G = gridDim.x, bx = blockIdx.x;
    const int vcu = (G % 8 == 0) ? (bx % 8) * (G / 8) + bx / 8 : bx;
    const int gw = vcu * NWAVES + wave, NGW = G * NWAVES;
    for (int u = tid; u < (LDS_BYTES - MISC_OFF) / 4; u += NWAVES * 64) ((LAS unsigned*)(lds + MISC_OFF))[u] = 0u;
    __syncthreads();
    int ph_lo, ph_hi; XcdBarrier bar;
    { CArgs* ap = phase_args(); ph_lo = ap->ph_lo; ph_hi = ap->ph_hi; unsigned* ctl = (unsigned*)(as_global(ap->ws) + WS_CTL);
      bar.bar = ctl + CW_BAR; bar.x = 0; bar.st = nullptr;
      if (ph_hi - ph_lo > 1) bar = xcd_barrier_post(ctl + CW_BAR, MISC + 8); }
    int phase = 0;
#define PH_BEGIN asm volatile("" : "+s"(phase)); if (ph_lo <= phase && phase < ph_hi) { CArgs& a = *phase_args(); unsigned char* const ws = as_global(a.ws); (void)ws; int tid_l; asm volatile("v_mbcnt_lo_u32_b32 %0, -1, 0\n\tv_mbcnt_hi_u32_b32 %0, -1, %0" : "=v"(tid_l)); tid_l += wave * 64; const int tid = tid_l, lane = tid & 63; (void)lane;
#define PH_END_NB } ++phase;
#define PH_END_IF(c) asm volatile("" : "+s"(phase)); if ((c) && phase + 1 < ph_hi) { XcdBarrier b2 = bar; asm volatile("" : "+s"(b2.bar), "+s"(b2.x)); b2.bar = as_global(b2.bar); xcd_barrier(b2); } } ++phase;
#define PH_END   asm volatile("" : "+s"(phase)); if (phase + 1 < ph_hi) { XcdBarrier b2 = bar; asm volatile("" : "+s"(b2.bar), "+s"(b2.x)); b2.bar = as_global(b2.bar); xcd_barrier(b2); } } ++phase;
#define MVEC ((float*)(ws + WS_MVEC))
#define COS64 ((float*)(ws + WS_ROPE))
#define SIN64 (COS64 + 2048 * 32)
#define COS128 (COS64 + 2 * 2048 * 32)
#define SIN128 (COS128 + 2048 * 64)
#define Hb ((bf16*)(ws + WS_H))
#define HQ ((unsigned char*)(ws + WS_HQ))
#define SAH ((float*)(ws + WS_SAH))
#define SWALL ((float*)(ws + WS_SWALL))
#define COLMAX ((unsigned*)(ws + WS_CTL + CTL_COLMAX))
#define H8 ((unsigned char*)(ws + WS_H))
#define HG8 ((unsigned char*)(ws + WS_HG))
#define ACT8 ((unsigned char*)(ws + S_ACT))
#define XRES ((bf16*)(ws + WS_XRES))
#define P ((bf16*)(ws + S_P))
#define OA ((bf16*)(ws + S_OA))
#define OB ((bf16*)(ws + S_OB))
#define OCAT ((bf16*)(ws + S_OCAT))
#define BB ((bf16*)(ws + S_BB))
#define Y2 ((bf16*)(ws + S_Y2))
#define Yb ((bf16*)(ws + S_Y))
#define YO ((bf16*)(ws + S_YO))
#define ACT ((bf16*)(ws + S_ACT))
#define FO ((bf16*)(ws + S_FO))
#define TOK_E ((int*)(ws + T_E))
#define TOK_W ((float*)(ws + T_W))
#define TOK_LP ((int*)(ws + T_LP))
#define TOK_SLOT ((int*)(ws + T_SLOT))
#define SLOT_W ((float*)(ws + T_SW))
#define CNTWG ((int*)(ws + T_CNT))
#define TSG ((int*)(ws + T_TS))

    PH_BEGIN
    {
        static_assert(NWAVES * 64 == 512, "cond fill indexing");
        LAS float* cond = (LAS float*)lds;
        LAS float* red = (LAS float*)(lds + 17 * 1024 * 4);
        for (int unit = vcu; unit < 2 * 192; unit += G) {
            const int l = unit / 192, n0 = (unit % 192) * 64;
            float accv[17][4];
#pragma unroll
            for (int r = 0; r < 17; ++r) { accv[r][0] = 0.f; accv[r][1] = 0.f; accv[r][2] = 0.f; accv[r][3] = 0.f; }
            for (int kh = 0; kh < 2; ++kh) {
                __syncthreads();
                { float cv_[34];
#pragma unroll
                  for (int m = 0; m < 34; ++m) { const int r = m >> 1, k = kh * 1024 + tid + 512 * (m & 1); cv_[m] = r < 16 ? as_global(a.c)[r * D + k] : as_global(a.c_ctx)[k]; }
#pragma unroll
                  for (int m = 0; m < 34; ++m) cond[(m >> 1) * 1024 + tid + 512 * (m & 1)] = cv_[m] * sigmoidf_(cv_[m]); }
                __syncthreads();
                const float* wp = as_global(a.w_mod) + ((size_t)l * D + kh * 1024 + wave * 128 + (lane >> 4)) * (6 * D) + n0 + (lane & 15) * 4;
                const LAS float* cp = cond + wave * 128 + (lane >> 4);
#pragma unroll 8
                for (int kk = 0; kk < 32; ++kk) { const f32x4 w = *(const f32x4*)(wp + (size_t)(4 * kk) * (6 * D));
#pragma unroll
                    for (int r = 0; r < 17; ++r) { const float cv = cp[r * 1024 + 4 * kk];
                        accv[r][0] = fmaf(cv, w[0], accv[r][0]); accv[r][1] = fmaf(cv, w[1], accv[r][1]); accv[r][2] = fmaf(cv, w[2], accv[r][2]); accv[r][3] = fmaf(cv, w[3], accv[r][3]); } }
            }
#pragma unroll
            for (int r = 0; r < 17; ++r)
#pragma unroll
                for (int e = 0; e < 4; ++e) { float v = accv[r][e]; v += shflx(v, 16, lane); v += shflx(v, 32, lane); accv[r][e] = v; }
            if (lane < 16) {
#pragma unroll
                for (int r = 0; r < 17; ++r) *(LAS f32x4*)(red + (wave * 17 + r) * 64 + lane * 4) = f32x4{accv[r][0], accv[r][1], accv[r][2], accv[r][3]}; }
            __syncthreads();
            for (int i = tid; i < 17 * 64; i += NWAVES * 64) { const int r = i >> 6, n = i & 63; float sacc = 0.f;
#pragma unroll
                for (int w = 0; w < 8; ++w) sacc += red[(w * 17 + r) * 64 + n];
                MVEC[((size_t)l * 17 + r) * (6 * D) + n0 + n] = sacc + as_global(a.b_mod)[(size_t)l * 6 * D + n0 + n]; }
        }
        __syncthreads();
        for (int i = bx * (NWAVES * 64) + tid; i < 2048 * 96; i += G * NWAVES * 64) {
            const int t = i / 96, j = i % 96; const float row = (float)(t >> 6), col = (float)(t & 63);
            if (j < 32) { const int q = j & 15; const float inv = __builtin_amdgcn_exp2f(-(float)q * (13.287712379549449f / 16.f)); const float ang = (j < 16 ? row : col) * inv; float sn, cs; sincosf(ang, &sn, &cs); COS64[t * 32 + j] = cs; SIN64[t * 32 + j] = sn; }
            else { const int jj = j - 32, q = jj & 31; const float inv = __builtin_amdgcn_exp2f(-(float)q * (13.287712379549449f / 32.f)); const float ang = (jj < 32 ? row : col) * inv; float sn, cs; sincosf(ang, &sn, &cs); COS128[t * 64 + jj] = cs; SIN128[t * 64 + jj] = sn; }
        }
#pragma unroll
        for (int q = 0; q < 5; ++q) if (q_enabled(q)) { const QMat qm = qmat(a, ws, q); unsigned* colmax = COLMAX + QOFF[q]; const int nblk = qm.N / 64;
          for (int it = gw; it < nblk * 8; it += NGW) { const int nb = it % nblk, ks = it / nblk, n0 = nb * 64, k0 = ks * 256;
              const float* src = qm.W + (size_t)(k0 + (lane >> 4)) * qm.N + n0 + ((lane & 15) << 2);
              f32x4 mx = {0.f, 0.f, 0.f, 0.f};
#pragma unroll 8
              for (int i = 0; i < 64; ++i) { const f32x4 v = *(const f32x4*)(src + (size_t)(4 * i) * qm.N);
#pragma unroll
                  for (int e = 0; e < 4; ++e) mx[e] = fmaxf(mx[e], fabsf(v[e])); }
#pragma unroll
              for (int e = 0; e < 4; ++e) { mx[e] = fmaxf(mx[e], shflx(mx[e], 16, lane)); mx[e] = fmaxf(mx[e], shflx(mx[e], 32, lane)); }
              if (lane < 16) {
#pragma unroll
                  for (int e = 0; e < 4; ++e) atomicMax(colmax + n0 + 4 * lane + e, __float_as_uint(mx[e])); } } }
    }
    PH_END

#define MOE_CONV() do { __syncthreads(); int ln_; asm volatile("v_mbcnt_lo_u32_b32 %0, -1, 0\n\tv_mbcnt_hi_u32_b32 %0, -1, %0" : "=v"(ln_));     \
        LAS float* scr_ = (LAS float*)(lds + wave * 16640); int base_ = 0;                                             \
        for (int id = 2; id < NMAT; ++id) { if (id == 12 || (id == 8 || id == 9)) continue;                                                                 \
            const int ni = mat_items(id); int it = gw - (base_ % NGW); if (it < 0) it += NGW;                                                               \
            if (it < ni) { MatDesc d; mat_desc(a, id, d);                                                                                                   \
                if (id < 14) transpose_run<0>(d.W, d.K, d.N, d.WT, d.map, scr_, it, ni, NGW, ln_);                                                         \
                else transpose_run<1>(d.W, d.K, d.N, d.WT, d.map, scr_, it, ni, NGW, ln_); } base_ += ni; }                                                \
        _Pragma("unroll") for (int q = 0; q < 5; ++q) if (q != 3) { const QMat qm = qmat(a, ws, q);                                                          \
            transpose_run<2>(qm.W, 2048, qm.N, qm.WT, qm.map, scr_, gw, (2048 / 64) * (qm.N / 64), NGW, ln_, COLMAX + QOFF[q], SWALL + QOFF[q]); }          \
        __syncthreads(); } while (0)
    const int cgrp = (G % 8 == 0) ? (vcu / (G / 8)) & 3 : (vcu & 3);
    static_assert(I8_GATES == 1 && I8_P1 == 3, "the attention-phase conversion chunk assumes matrices 0, 1, 8, 9, 12 are the int8 ones (quantised in the R1 phase)");
#pragma unroll 1
    for (int l = 0; l < 2; ++l) {
        const bool last_layer = (l == 1);
        const float lam_init = l == 0 ? 0.2f : 0.35550906759096924f;
        const int nMv = l == 0 ? M / 256 : NTOK / 256, skipctx = l == 0 ? 0 : 1;

        PH_BEGIN
        if (l == 0) {
            const float* ng = as_global(a.norm_g); const float* mv = MVEC;
            for (int row = gw; row < M; row += NGW) {
                const int b = row / TPB, pos = row - b * TPB; const int r = pos < CTXL ? 16 : b;
                const float* src = pos < CTXL ? as_global(a.ctx) + ((size_t)b * CTXL + pos) * D : as_global(a.x) + ((size_t)b * SEQ + (pos - CTXL)) * D;
                float xv[32]; float ss = 0.f;
#pragma unroll
                for (int j = 0; j < 4; ++j) { const f32x4 v0 = *(const f32x4*)(src + 512 * j + 8 * lane), v1 = *(const f32x4*)(src + 512 * j + 8 * lane + 4);
#pragma unroll
                    for (int e = 0; e < 4; ++e) { xv[8 * j + e] = v0[e]; xv[8 * j + 4 + e] = v1[e]; ss += v0[e] * v0[e] + v1[e] * v1[e]; }
                }
                const float rstd = rsqrtf(wave_sum(ss, lane) * (1.f / D) + EPS);
                const float* msh = mv + (size_t)r * 6 * D, *msc = msh + D;
                float am = 0.f;
#pragma unroll
                for (int j = 0; j < 4; ++j) { float o[8]; const int c0 = 512 * j + 8 * lane;
#pragma unroll
                    for (int e = 0; e < 8; ++e) { o[e] = xv[8 * j + e] * rstd * ng[c0 + e] * (1.f + msc[c0 + e]) + msh[c0 + e]; xv[8 * j + e] = o[e]; am = fmaxf(am, fabsf(o[e])); }
                    if (!(I8_GATES && (I8_P1 & 1))) *(u32x4*)(Hb + (size_t)row * D + c0) = pack8(o); }
                if (I8_GATES || (I8_P1 & 1)) {
#pragma unroll
                    for (int o_ = 1; o_ < 64; o_ <<= 1) am = fmaxf(am, shflx(am, o_, lane));
                    const float inv = am > 0.f ? 127.f / am : 0.f;
#pragma unroll
                    for (int j = 0; j < 4; ++j) { float q8[8];
#pragma unroll
                        for (int e = 0; e < 8; ++e) q8[e] = xv[8 * j + e] * inv;
                        *(u32x2*)(HQ + (size_t)row * D + 512 * j + 8 * lane) = pack8_i8(q8); }
                    if (lane == 0) SAH[row] = am * (1.f / 127.f);
                }
            }
            {
                LAS float* scr = (LAS float*)(lds + wave * 16640);
#pragma unroll
                for (int q = 3; q < 4; ++q) if (q_enabled(q)) { const QMat qm = qmat(a, ws, q);
                    transpose_run<2>(qm.W, 2048, qm.N, qm.WT, qm.map, scr, gw, (2048 / 64) * (qm.N / 64), NGW, lane, COLMAX + QOFF[q], SWALL + QOFF[q]); }
            }
        }
        PH_END_IF(l == 0)

        PH_BEGIN
        {
            pg8::Sched S{(const char*)Hb, (const char*)(ws + WS_WIN) + (size_t)l * WIN * 2048 * 2, 4096, 4096, l == 0 ? M / 256 : NTOK / 256, WIN / 256, G, bx, l == 0 ? 0 : 1, 1 << 20, 0, nullptr, 0, l == 0 ? 0 : 256};
            if ((I8_P1 >> l) & 1) {
                S.A = (const char*)HQ; S.B = (const char*)(ws + WS_WIN) + (size_t)l * WIN * 2048; S.ldaB = 2048; S.kB = 2048;
                pg8::EpiStore<true> E{P, WIN, nullptr, 1.f, SAH, SWALL + QOFF[3 + l]};
                pg8::gemm_phase<pg8::EpiStore<true>, 2>(lds, S, E, tid);
            } else {
                pg8::EpiStore<false> E{P, WIN, nullptr, 1.f, nullptr, nullptr};
                pg8::gemm_phase<pg8::EpiStore<false>, 0>(lds, S, E, tid);
            }
        }
        PH_END

        PH_BEGIN
        {
            const float* qg = as_global(a.qk_g) + (size_t)l * 2 * 128 + 128;
            for (int row = gw; row < M; row += NGW) {
                const int b = row / TPB, pos = row - b * TPB; const bool lat = pos >= CTXL; const int t = pos - CTXL;
                bf16* pr = P + (size_t)row * WIN;
                if (lat) { const int v = lane >> 2, c = lane & 3; bf16* p1 = pr + O_AK + v * 64 + 8 * c; bf16* p2 = p1 + 32;
                    float x1[8], x2[8], o1[8], o2[8]; unpack8(*(const u32x4*)p1, x1); unpack8(*(const u32x4*)p2, x2);
                    const float* cs = COS64 + t * 32 + 8 * c; const float* sn = SIN64 + t * 32 + 8 * c;
#pragma unroll
                    for (int e = 0; e < 8; ++e) { o1[e] = x1[e] * cs[e] - x2[e] * sn[e]; o2[e] = x2[e] * cs[e] + x1[e] * sn[e]; }
                    *(u32x4*)p1 = pack8(o1); *(u32x4*)p2 = pack8(o2); }
                {
                    const bool isB = lane < 32, isC = lane >= 32 && lane < 48; const int v = isB ? (lane >> 3) : ((lane >> 3) & 1), c = lane & 7;
                    bf16* p1 = pr + (isB ? O_BK : O_CK) + v * 128 + 8 * c; bf16* p2 = p1 + 64;
                    float x1[8], x2[8], o1[8], o2[8]; unpack8(*(const u32x4*)p1, x1); unpack8(*(const u32x4*)p2, x2);
                    float ss = 0.f;
#pragma unroll
                    for (int e = 0; e < 8; ++e) ss += x1[e] * x1[e] + x2[e] * x2[e];
                    ss += shflx(ss, 1, lane); ss += shflx(ss, 2, lane); ss += shflx(ss, 4, lane);
                    const float rstd = isC ? rsqrtf(ss * (1.f / 128.f) + EPS) : 1.f;
#pragma unroll
                    for (int e = 0; e < 8; ++e) { x1[e] *= rstd * (isC ? qg[8 * c + e] : 1.f); x2[e] *= rstd * (isC ? qg[64 + 8 * c + e] : 1.f); }
                    if (lat) { const float* cs = COS128 + t * 64 + 8 * c; const float* sn = SIN128 + t * 64 + 8 * c;
#pragma unroll
                        for (int e = 0; e < 8; ++e) { o1[e] = x1[e] * cs[e] - x2[e] * sn[e]; o2[e] = x2[e] * cs[e] + x1[e] * sn[e]; } }
                    else {
#pragma unroll
                        for (int e = 0; e < 8; ++e) { o1[e] = x1[e]; o2[e] = x2[e]; } }
                    if (isC || (isB && lat)) { *(u32x4*)p1 = pack8(o1); *(u32x4*)p2 = pack8(o2); }
                }
            }
        }
        PH_END

        PH_BEGIN
        {
            const att::RetP rp0{0.f, 0.f, 0.f, 0, 0};
            const float* dl = as_global(a.dlam) + (size_t)l * 4 * 64;
            const float lam = __expf(wave_sum(dl[lane] * dl[64 + lane], lane)) - __expf(wave_sum(dl[128 + lane] * dl[192 + lane], lane)) + lam_init;
            const float* sg = as_global(a.subln) + (size_t)l * 128;
            const int npair = 1024 + (l == 0 ? 128 : 0);
            if (l == 0 && cgrp == 0) MOE_CONV();
            for (int i = 0; ; ++i) {
                const int pu = vcu + (i >> 1) * G; if (pu >= npair) break;
                const int s = i & 1;
                int tid_u; asm volatile("v_mbcnt_lo_u32_b32 %0, -1, 0\n\tv_mbcnt_hi_u32_b32 %0, -1, %0" : "=v"(tid_u)); tid_u += wave * 64;
                int b, h, q0, seq, t0;
                if (pu < 1024) { const int qb = pu & 7; h = (pu >> 3) & 7; b = pu >> 6; q0 = b * TPB + CTXL + qb * 256; seq = TPB; t0 = qb * 256; }
                else { const int v = pu - 1024; h = v & 7; b = v >> 3; q0 = b * TPB; seq = CTXL; t0 = -1; }
                const int k0 = b * TPB;
                att::attn_unit<1, 2>(P + (size_t)q0 * WIN + O_AQ + h * 128 + s * 64, P + (size_t)k0 * WIN + O_AK + h * 128, P + (size_t)k0 * WIN + O_AV + h * 128,
                                  OCAT + (size_t)q0 * 3072 + h * 128, 3072, seq, 0.125f, s * 128, rp0, (LAS char*)lds, tid_u, att::QFix{nullptr, COS64, SIN64, t0},
                                  att::Fuse{1 + s, lam, 1.f - lam_init, sg, nullptr});
            }
            if (l == 0 && cgrp == 1) MOE_CONV();
        }
        PH_END_NB
        PH_BEGIN
        {
            const att::RetP rp0{0.f, 0.f, 0.f, 0, 0};
            const int nctx = l == 0 ? 128 : 0;
            const int vc2 = (G % 64 == 0) ? (vcu + G / 2) % G : vcu;
            for (int u = vc2; u < 1024 + nctx; u += G) {
                int tid_u; asm volatile("v_mbcnt_lo_u32_b32 %0, -1, 0\n\tv_mbcnt_hi_u32_b32 %0, -1, %0" : "=v"(tid_u)); tid_u += wave * 64;
                int b, hq, q0, seq, t0;
                if (u < 1024) { const int qb = u & 7; hq = (u >> 3) & 7; b = u >> 6; q0 = b * TPB + CTXL + qb * 256; seq = TPB; t0 = qb * 256; }
                else { const int v = u - 1024; hq = v & 7; b = v >> 3; q0 = b * TPB; seq = CTXL; t0 = -1; }
                const int k0 = b * TPB, kvh = hq >> 2;
                att::attn_unit<0, 2>(P + (size_t)q0 * WIN + O_CQ + hq * 128, P + (size_t)k0 * WIN + O_CK + kvh * 128, P + (size_t)k0 * WIN + O_CV + kvh * 128,
                                  OCAT + (size_t)q0 * 3072 + 2048 + hq * 128, 3072, seq, 0.08838834764831845f, 0, rp0, (LAS char*)lds, tid_u, att::QFix{as_global(a.qk_g) + (size_t)l * 256, COS128, SIN128, t0},
                                  att::Fuse{0, 0.f, 0.f, nullptr, nullptr});
            }
            if (l == 0 && cgrp == 2) MOE_CONV();
        }
        PH_END_NB
        PH_BEGIN
        {
            const int npair = 512 + (l == 0 ? 64 : 0);
            const int vc3 = (G % 64 == 0) ? (vcu + G / 4) % G : vcu;
            for (int i = 0; ; ++i) {
                const int pu = vc3 + (i >> 1) * G; if (pu >= npair) break;
                const int vh = i & 1;
                int tid_u; asm volatile("v_mbcnt_lo_u32_b32 %0, -1, 0\n\tv_mbcnt_hi_u32_b32 %0, -1, %0" : "=v"(tid_u)); tid_u += wave * 64;
                int b, h, q0, seq, qs0, latq, t0;
                if (pu < 512) { const int qb = pu & 7; h = (pu >> 3) & 3; b = pu >> 5; q0 = b * TPB + CTXL + qb * 256; seq = TPB; qs0 = CTXL + qb * 256; latq = 1; t0 = qb * 256; }
                else { const int v = pu - 512; h = v & 3; b = v >> 2; q0 = b * TPB; seq = CTXL; qs0 = 0; latq = 0; t0 = -1; }
                const int k0 = b * TPB;
                const att::RetP rp{as_global(a.rdecay)[(l * 2 + 0) * 4 + h] * LOG2E, as_global(a.rdecay)[(l * 2 + 1) * 4 + h] * LOG2E, -3.5f, qs0, latq};
                att::attn_unit<2, 2>(P + (size_t)q0 * WIN + O_BQ + h * 128, P + (size_t)k0 * WIN + O_BK + h * 128, P + (size_t)k0 * WIN + O_BV + h * 256 + vh * 128,
                                  OCAT + (size_t)q0 * 3072 + 1024 + h * 256, 3072, seq, 1.f, 0, rp, (LAS char*)lds, tid_u, att::QFix{nullptr, COS128, SIN128, t0},
                                  att::Fuse{1 + vh, 0.f, 0.f, nullptr, P + (size_t)q0 * WIN + O_BG + h * 256});
            }
            if (l == 0 && cgrp == 3) MOE_CONV();
        }
        PH_END

        PH_BEGIN
        PH_END_NB

        PH_BEGIN
        {
            pg8::Sched S{(const char*)OCAT, (const char*)(ws + WS_WB) + (size_t)l * 3 * 2048 * 1024 * 2, 6144, 2048, nMv, 24, G, bx, skipctx, 8, 2048, nullptr, 0, 0};
            pg8::EpiStore<false> E{BB, 6144, nullptr, 1.f, nullptr, nullptr};
            pg8::gemm_phase<pg8::EpiStore<false>, 0>(lds, S, E, tid);
        }
        PH_END
        PH_BEGIN
        {
            pg8::Sched S{(const char*)Hb, (const char*)(ws + WS_WG) + ((size_t)l * 6144 + 4096) * 2048 * 2, 4096, 4096, nMv, 8, G, bx, skipctx, 1 << 20, 0, nullptr, 0, 0};
            if (I8_GATES) {
                S.A = (const char*)HQ; S.B = (const char*)(ws + WS_WG) + ((size_t)l * 6144 + 4096) * 2048; S.ldaB = 2048; S.kB = 2048;
                pg8::EpiG2<true> E{Y2, BB, SAH, SWALL + QOFF[1 + l] + 4096};
                pg8::gemm_phase<pg8::EpiG2<true>, 2>(lds, S, E, tid);
            } else {
                pg8::EpiG2<false> E{Y2, BB, nullptr, nullptr};
                pg8::gemm_phase<pg8::EpiG2<false>, 0>(lds, S, E, tid);
            }
        }
        PH_END
        PH_BEGIN
        {
            pg8::Sched S{(const char*)Hb, (const char*)(ws + WS_WG) + (size_t)l * 6144 * 2048 * 2, 4096, 4096, nMv, 16, G, bx, skipctx, 1 << 20, 0, nullptr, 0, 0};
            if (I8_GATES) {
                S.A = (const char*)HQ; S.B = (const char*)(ws + WS_WG) + (size_t)l * 6144 * 2048; S.ldaB = 2048; S.kB = 2048;
                pg8::EpiG01<true> E{Yb, Y2, BB, (DBG_BRANCH_MASK >> 0) & 1, (DBG_BRANCH_MASK >> 1) & 1, (DBG_BRANCH_MASK >> 2) & 1, SAH, SWALL + QOFF[1 + l]};
                pg8::gemm_phase<pg8::EpiG01<true>, 2>(lds, S, E, tid);
            } else {
                pg8::EpiG01<false> E{Yb, Y2, BB, (DBG_BRANCH_MASK >> 0) & 1, (DBG_BRANCH_MASK >> 1) & 1, (DBG_BRANCH_MASK >> 2) & 1, nullptr, nullptr};
                pg8::gemm_phase<pg8::EpiG01<false>, 0>(lds, S, E, tid);
            }
        }
        PH_END
        PH_BEGIN
        {
            pg8::Sched S{(const char*)Yb, (const char*)(ws + WS_WO) + (size_t)l * 2048 * 2048 * 2, 4096, 4096, nMv, 8, G, bx, skipctx, 1 << 20, 0, nullptr, 0, 0};
            pg8::EpiStore<false> E{YO, 2048, nullptr, 1.f, nullptr, nullptr};
            pg8::gemm_phase<pg8::EpiStore<false>, 0>(lds, S, E, tid);
        }
        PH_END

        PH_BEGIN
        {
            LAS float* rt = (LAS float*)lds;
            LAS int* lcnt = (LAS int*)(lds + MISC_OFF + 256);
            if (l == 1) {
                for (int i = tid; i < 8 * 2048; i += NWAVES * 64) { const int e = i >> 11, k = i & 2047; rt[i] = as_global(a.moe_router)[(size_t)k * 8 + e]; }
                if (tid < 8) lcnt[tid] = 0;
                __syncthreads();
            }
            const float* ng = as_global(a.norm_g) + (size_t)l * 4 * D; const float* mv = MVEC + (size_t)l * 17 * 6 * D;
            const int per = l == 0 ? M / 2048 : NTOK / 2048;
            const int nrows = l == 0 ? M : NTOK;
            for (int it0 = gw * per; it0 < nrows; it0 += NGW * per)
            for (int it = it0; it < it0 + per; ++it) {
                const int row = l == 0 ? it : lat_row(it);
                const int b = row / TPB, pos = row - b * TPB; const int r = pos < CTXL ? 16 : b;
                const float* mr = mv + (size_t)r * 6 * D;
                float yv[32]; float ss = 0.f;
#pragma unroll
                for (int j = 0; j < 4; ++j) { float t8[8]; unpack8(*(const u32x4*)(YO + (size_t)row * D + 512 * j + 8 * lane), t8);
#pragma unroll
                    for (int e = 0; e < 8; ++e) { yv[8 * j + e] = t8[e]; ss += t8[e] * t8[e]; } }
                const float rstd_y = rsqrtf(wave_sum(ss, lane) * (1.f / D) + EPS);
                bf16* xp = XRES + (size_t)row * D;
                const void* xsrc = l == 1 ? (const void*)xp : (const void*)(pos < CTXL ? as_global(a.ctx) + ((size_t)b * CTXL + pos) * D : as_global(a.x) + ((size_t)b * SEQ + (pos - CTXL)) * D);
                row_update(xsrc, l == 0, xp, false, yv, rstd_y, mr + 2 * D, ng + D, true, ng + 2 * D, mr + 4 * D, mr + 3 * D, nullptr, H8 + (size_t)row * D, l == 0 ? (float*)(ws + T_SA) + row : nullptr, lane);
                if (l == 1) {
                    float lg[8];
#pragma unroll
                    for (int e = 0; e < 8; ++e) { float s = 0.f;
#pragma unroll
                        for (int j = 0; j < 4; ++j) { const f32x4 r0 = *(const LAS f32x4*)(rt + e * 2048 + 512 * j + 8 * lane), r1 = *(const LAS f32x4*)(rt + e * 2048 + 512 * j + 8 * lane + 4);
#pragma unroll
                            for (int q = 0; q < 4; ++q) s += yv[8 * j + q] * r0[q] + yv[8 * j + 4 + q] * r1[q]; }
                        lg[e] = wave_sum(s, lane); }
                    int e1 = 0; float v1 = lg[0];
#pragma unroll
                    for (int e = 1; e < 8; ++e) if (lg[e] > v1) { v1 = lg[e]; e1 = e; }
                    int e2 = 0; float v2 = -3.4e38f;
#pragma unroll
                    for (int e = 0; e < 8; ++e) if (e != e1 && lg[e] > v2) { v2 = lg[e]; e2 = e; }
                    const float w1 = 1.f / (1.f + __expf(v2 - v1)), w2 = 1.f - w1;
                    if (lane == 0) { const int p1 = __hip_atomic_fetch_add(&lcnt[e1], 1, __ATOMIC_RELAXED, __HIP_MEMORY_SCOPE_WORKGROUP), p2 = __hip_atomic_fetch_add(&lcnt[e2], 1, __ATOMIC_RELAXED, __HIP_MEMORY_SCOPE_WORKGROUP);
                        TOK_E[2 * it] = e1; TOK_E[2 * it + 1] = e2; TOK_W[2 * it] = w1; TOK_W[2 * it + 1] = w2; TOK_LP[2 * it] = p1; TOK_LP[2 * it + 1] = p2; }
                }
            }
            if (l == 1) { __syncthreads(); if (tid < 8) CNTWG[vcu * 8 + tid] = lcnt[tid]; }
            else if (bx == 0 && tid < 9) TSG[tid] = tid == 0 ? 0 : M / 256;
        }
        PH_END

        PH_BEGIN
        if (l == 1) {
            LAS int* tab = (LAS int*)lds;
            LAS int* pre = (LAS int*)(lds + MISC_OFF + 256 + 64); LAS int* tsl = (LAS int*)(lds + MISC_OFF + 256 + 128);
            for (int i = tid; i < G * 8; i += NWAVES * 64) tab[i] = CNTWG[i];
            __syncthreads();
            if (tid < 8) { int tot = 0, p = 0; for (int w = 0; w < G; ++w) { const int v = tab[w * 8 + tid]; p += (w < vcu) ? v : 0; tot += v; } pre[tid] = p; pre[8 + tid] = tot; }
            __syncthreads();
            if (tid == 0) { int t = 0; tsl[0] = 0; for (int e = 0; e < 8; ++e) { t += (pre[8 + e] + 255) >> 8; tsl[e + 1] = t; } }
            __syncthreads();
            if (bx == 0 && tid < 9) TSG[tid] = tsl[tid];
            const int per = NTOK / 2048;
            for (int it0 = gw * per; it0 < NTOK; it0 += NGW * per)
            for (int it = it0; it < it0 + per; ++it) {
                const int row = lat_row(it);
#pragma unroll
                for (int k = 0; k < 2; ++k) { const int e = TOK_E[2 * it + k]; const int slot = 256 * tsl[e] + pre[e] + TOK_LP[2 * it + k];
                    const u32x4* s = (const u32x4*)(H8 + (size_t)row * D); u32x4* d = (u32x4*)(HG8 + (size_t)slot * D);
#pragma unroll
                    for (int j = 0; j < 2; ++j) d[64 * j + lane] = s[64 * j + lane];
                    if (lane == 0) { SLOT_W[slot] = TOK_W[2 * it + k]; TOK_SLOT[2 * it + k] = slot; } }
            }
        }
        PH_END_IF(l == 1)

        PH_BEGIN
        {
            LAS int* tsl = (LAS int*)(lds + MISC_OFF + 512);
            if (tid < 9) tsl[tid] = TSG[tid];
            __syncthreads();
            if (l == 0) {
                pg8::Sched S{(const char*)H8, (const char*)(ws + WS_WF1), 2048, 2048, tsl[8], 44, G, bx, 0, 1 << 20, 0, tsl, 0, 0};
                pg8::EpiSwiGLU<false, true> E{ACT, 1.f, (const float*)(ws + T_SA), SWALL + QOFF[0]};
                pg8::gemm_phase<pg8::EpiSwiGLU<false, true>, 2>(lds, S, E, tid);
            } else {
                pg8::Sched S{(const char*)HG8, (const char*)(ws + WS_WM1), 2048, 2048, tsl[8], 44, G, bx, 0, 1 << 20, 0, tsl, (size_t)2 * FF * 2048, 0};
                pg8::EpiSwiGLU<true, false> E{ACT8, 1.f / W8SCALE, nullptr, nullptr};
                pg8::gemm_phase<pg8::EpiSwiGLU<true, false>, 1>(lds, S, E, tid);
            }
        }
        PH_END
        PH_BEGIN
        {
            LAS int* tsl = (LAS int*)(lds + MISC_OFF + 512);
            if (tid < 9) tsl[tid] = TSG[tid];
            __syncthreads();
            if (l == 0) {
                pg8::Sched S{(const char*)ACT, (const char*)(ws + WS_WF2), 2 * FF, 2 * FF, tsl[8], 8, G, bx, 0, 1 << 20, 0, tsl, 0, 0};
                pg8::EpiStore<false> E{FO, 2048, nullptr, 1.f, nullptr, nullptr};
                pg8::gemm_phase<pg8::EpiStore<false>, 0>(lds, S, E, tid);
            } else {
                pg8::Sched S{(const char*)ACT8, (const char*)(ws + WS_WM2), FF, FF, tsl[8], 8, G, bx, 0, 1 << 20, 0, tsl, (size_t)2048 * FF, 0};
                pg8::EpiStore<false> E{FO, 2048, SLOT_W, 1.f / W8SCALE, nullptr, nullptr};
                pg8::gemm_phase<pg8::EpiStore<false>, 1>(lds, S, E, tid);
            }
        }
        PH_END

        PH_BEGIN
        {
            const int per = l == 0 ? M / 2048 : NTOK / 2048; const int nrows = l == 0 ? M : NTOK;
            const float* ng = as_global(a.norm_g) + (size_t)l * 4 * D; const float* mv = MVEC + (size_t)l * 17 * 6 * D;
            const int ln = last_layer ? l : l + 1;
            const float* ngn = as_global(a.norm_g) + (size_t)ln * 4 * D; const float* mvn = MVEC + (size_t)ln * 17 * 6 * D;
            for (int it0 = gw * per; it0 < nrows; it0 += NGW * per)
            for (int it = it0; it < it0 + per; ++it) {
                const int row = l == 0 ? it : lat_row(it);
                const int b = row / TPB, pos = row - b * TPB; const int r = pos < CTXL ? 16 : b;
                const float* mr = mv + (size_t)r * 6 * D; const float* mn = mvn + (size_t)r * 6 * D;
                float yv[32]; float ss = 0.f;
                const bf16* f0 = FO + (size_t)(l == 0 ? row : TOK_SLOT[2 * it]) * D; const bf16* f1 = FO + (size_t)(l == 0 ? row : TOK_SLOT[2 * it + 1]) * D;
#pragma unroll
                for (int j = 0; j < 4; ++j) { float t8[8]; unpack8(*(const u32x4*)(f0 + 512 * j + 8 * lane), t8);
                    if (l == 1) { float u8[8]; unpack8(*(const u32x4*)(f1 + 512 * j + 8 * lane), u8);
#pragma unroll
                        for (int e = 0; e < 8; ++e) t8[e] += u8[e]; }
#pragma unroll
                    for (int e = 0; e < 8; ++e) { yv[8 * j + e] = t8[e]; ss += t8[e] * t8[e]; } }
                const float rstd_y = rsqrtf(wave_sum(ss, lane) * (1.f / D) + EPS);
                bf16* xp = XRES + (size_t)row * D;
                row_update(xp, false, last_layer ? (void*)(as_global(a.out) + (size_t)it * D) : (void*)xp, last_layer, yv, rstd_y, mr + 5 * D, ng + 3 * D, !last_layer, ngn, mn + D, mn, (I8_GATES && (I8_P1 & 2)) ? (bf16*)nullptr : Hb + (size_t)row * D, (I8_GATES || (I8_P1 & 2)) ? HQ + (size_t)row * D : nullptr, (I8_GATES || (I8_P1 & 2)) ? SAH + row : nullptr, lane);
            }
        }
        PH_END
    }
#undef PH_BEGIN
#undef PH_END
#undef PH_END_NB
#undef PH_END_IF
}

constexpr int N_PHASES = 1 + 2 * 16;
#ifndef MK_ONE_LAUNCH
#define MK_ONE_LAUNCH 1
#endif
extern "C" void kernel_launch(void* const* d_in, const int* in_sizes, int n_in, void* d_out, int out_size, void* d_ws, size_t ws_size, hipStream_t stream) {
    static int grid = 0;
    if (grid == 0) {
        if (n_in != 20 || out_size != NTOK * D || ws_size < WS_END) { fprintf(stderr, "kernel_launch: unexpected shapes: n_in %d out %d ws %zu (need %zu)\n", n_in, out_size, ws_size, (size_t)WS_END); grid = -1; return; }
        int dev = 0, cus = 0, per_cu = 0;
        if (hipGetDevice(&dev) != hipSuccess || hipDeviceGetAttribute(&cus, hipDeviceAttributeMultiprocessorCount, dev) != hipSuccess) { grid = -1; return; }
        if (hipFuncSetAttribute((const void*)fwd_kernel, hipFuncAttributeMaxDynamicSharedMemorySize, LDS_BYTES) != hipSuccess) { fprintf(stderr, "kernel_launch: hipFuncSetAttribute failed\n"); grid = -1; return; }
        if (hipOccupancyMaxActiveBlocksPerMultiprocessor(&per_cu, (const void*)fwd_kernel, NWAVES * 64, LDS_BYTES) != hipSuccess || per_cu < 1)
            fprintf(stderr, "kernel_launch: note: occupancy query reports %d workgroups per CU\n", per_cu);
        (void)hipGetLastError();
        grid = cus;
    }
    if (grid < 0) return;
    if (hipMemsetAsync((char*)d_ws + WS_CTL, 0, CTL_ZERO_BYTES, stream) != hipSuccess) { fprintf(stderr, "kernel_launch: memset failed\n"); return; }
    Args a{};
    a.x = (const float*)d_in[0]; a.c = (const float*)d_in[1]; a.ctx = (const float*)d_in[2]; a.c_ctx = (const float*)d_in[3]; a.w_mod = (const float*)d_in[4]; a.b_mod = (const float*)d_in[5];
    a.norm_g = (const float*)d_in[6]; a.w_in = (const float*)d_in[7]; a.qk_g = (const float*)d_in[8]; a.dlam = (const float*)d_in[9]; a.subln = (const float*)d_in[10]; a.rdecay = (const float*)d_in[11];
    a.w_branch = (const float*)d_in[12]; a.w_bgate = (const float*)d_in[13]; a.w_out = (const float*)d_in[14]; a.ffn_w_in = (const float*)d_in[15]; a.ffn_w_out = (const float*)d_in[16];
    a.moe_router = (const float*)d_in[17]; a.moe_w_in = (const float*)d_in[18]; a.moe_w_out = (const float*)d_in[19];
    a.out = (float*)d_out; a.ws = (unsigned char*)d_ws;
#if MK_ONE_LAUNCH
    a.ph_lo = 0; a.ph_hi = N_PHASES;
    hipLaunchKernelGGL(fwd_kernel, dim3(grid), dim3(NWAVES * 64), LDS_BYTES, stream, a);
#else
    for (int p = 0; p < N_PHASES; ++p) { a.ph_lo = p; a.ph_hi = p + 1; hipLaunchKernelGGL(fwd_kernel, dim3(grid), dim3(NWAVES * 64), LDS_BYTES, stream, a); }
#endif
    const hipError_t le = hipPeekAtLastError();
    if (le != hipSuccess) fprintf(stderr, "kernel_launch: launch failed: %s\n", hipGetErrorName(le));
}
```

```cpp
#include <hip/hip_runtime.h>
#include <cstdio>
#include <cstdint>

#define GAS __attribute__((address_space(1)))
#define LAS __attribute__((address_space(3)))
typedef unsigned short bf16;
typedef short bf16x8 __attribute__((ext_vector_type(8)));
typedef short s16x4 __attribute__((ext_vector_type(4)));
typedef float f32x4 __attribute__((ext_vector_type(4)));
typedef float f32x16 __attribute__((ext_vector_type(16)));
typedef unsigned u32x4 __attribute__((ext_vector_type(4)));
typedef unsigned u32x2 __attribute__((ext_vector_type(2)));

#ifndef I8_GATES
#define I8_GATES 1
#endif
#ifndef I8_P1
#define I8_P1 3
#endif
#ifndef DBG_BRANCH_MASK
#define DBG_BRANCH_MASK 7
#endif

constexpr int D = 2048, NB = 16, SEQ = 2048, CTXL = 256, TPB = SEQ + CTXL, M = NB * TPB;
constexpr int WIN = 7680, FF = 5632, NE = 8, NTOK = NB * SEQ;
constexpr int O_AQ = 0, O_AK = 1024, O_AV = 2048, O_BQ = 3072, O_BK = 3584, O_BV = 4096, O_BG = 5120, O_CQ = 6144, O_CK = 7168, O_CV = 7424;
constexpr int NSLOT = 2 * NTOK + NE * 256;
constexpr float EPS = 1e-6f, GN_EPS = 1e-5f, LOG2E = 1.4426950408889634f;

constexpr size_t MiB = 1u << 20;
constexpr size_t WS_CTL = 0, CTL_ZERO_BYTES = 1 * MiB;
constexpr size_t WS_MVEC = 4 * MiB;
constexpr size_t WS_ROPE = 6 * MiB;
constexpr size_t WS_TOK = 8 * MiB;
constexpr size_t WS_WIN = 10 * MiB;
constexpr size_t WS_WB = WS_WIN + 60 * MiB;
constexpr size_t WS_WG = WS_WB + 24 * MiB;
constexpr size_t WS_WO = WS_WG + 48 * MiB;
constexpr size_t WS_WF1 = WS_WO + 16 * MiB;
constexpr size_t WS_WF2 = WS_WF1 + 44 * MiB;
constexpr size_t WS_WM1 = WS_WF2 + 22 * MiB;
constexpr size_t WS_WM2 = WS_WM1 + 352 * MiB;
constexpr size_t WS_XRES = WS_WM2 + 176 * MiB;
constexpr size_t WS_H = WS_XRES + 288 * MiB;
constexpr size_t WS_HG = WS_H + 144 * MiB;
constexpr size_t WS_S = WS_HG + 264 * MiB;
constexpr size_t S_P = WS_S;
constexpr size_t S_OA = WS_S + 540 * MiB;
constexpr size_t S_OB = WS_S + 684 * MiB;
constexpr size_t S_OCAT = WS_S + 756 * MiB;
constexpr size_t S_BB = WS_S;
constexpr size_t S_Y2 = S_OA;
constexpr size_t S_Y = S_OCAT;
constexpr size_t S_YO = WS_S;
constexpr size_t S_ACT = WS_S;
constexpr size_t S_FO = S_OCAT;
constexpr size_t WS_END = WS_S + 1044 * MiB;
static_assert(WS_END <= (size_t)2800 * MiB, "workspace map");
constexpr size_t T_E = WS_TOK, T_W = T_E + 256 * 1024, T_LP = T_W + 256 * 1024, T_SLOT = T_LP + 256 * 1024, T_SW = T_SLOT + 256 * 1024,
                 T_CNT = T_SW + 512 * 1024, T_TS = T_CNT + 64 * 1024, T_SA = T_TS + 8 * 1024;
static_assert(T_SA + 152 * 1024 <= WS_WIN, "routing / scale tables fit below the weight copies");
constexpr int CW_BAR = 4096;
constexpr size_t CTL_COLMAX = 256 * 1024;
constexpr int QOFF[6] = {0, 11264, 17408, 23552, 31232, 38912};
constexpr size_t WS_SWALL = WS_MVEC + 1792 * 1024;
constexpr size_t WS_SAH = WS_ROPE + 1536 * 1024;
constexpr size_t WS_HQ = WS_XRES + 144 * MiB;

constexpr int RING_BYTES = 131072;
constexpr int MISC_OFF = 135168;
constexpr int LDS_BYTES = 147456;

template <class T> __device__ __forceinline__ T* as_global(T* p) { return (T*)(GAS T*)p; }
__device__ __forceinline__ unsigned f2bf(float f) { unsigned u = __builtin_bit_cast(unsigned, f); return (u + 0x7fffu + ((u >> 16) & 1u)) >> 16; }
__device__ __forceinline__ unsigned pk2(float lo, float hi) { return f2bf(lo) | (f2bf(hi) << 16); }
__device__ __forceinline__ unsigned cvt_pk_bf16(float lo, float hi) { unsigned r; asm volatile("v_cvt_pk_bf16_f32 %0, %1, %2" : "=v"(r) : "v"(lo), "v"(hi)); return r; }
__device__ __forceinline__ float bflo(unsigned u) { return __builtin_bit_cast(float, u << 16); }
__device__ __forceinline__ float bfhi(unsigned u) { return __builtin_bit_cast(float, u & 0xffff0000u); }
__device__ __forceinline__ void unpack8(u32x4 w, float (&v)[8]) { v[0] = bflo(w.x); v[1] = bfhi(w.x); v[2] = bflo(w.y); v[3] = bfhi(w.y); v[4] = bflo(w.z); v[5] = bfhi(w.z); v[6] = bflo(w.w); v[7] = bfhi(w.w); }
__device__ __forceinline__ u32x4 pack8(const float (&v)[8]) { u32x4 w; w.x = cvt_pk_bf16(v[0], v[1]); w.y = cvt_pk_bf16(v[2], v[3]); w.z = cvt_pk_bf16(v[4], v[5]); w.w = cvt_pk_bf16(v[6], v[7]); return w; }
__device__ __forceinline__ float clamp8(float x) { return fminf(fmaxf(x, -448.f), 448.f); }
__device__ __forceinline__ u32x2 pack8_fp8(const float (&v)[8]) {
    unsigned w0 = 0, w1 = 0;
    w0 = __builtin_amdgcn_cvt_pk_fp8_f32(clamp8(v[0]), clamp8(v[1]), w0, false); w0 = __builtin_amdgcn_cvt_pk_fp8_f32(clamp8(v[2]), clamp8(v[3]), w0, true);
    w1 = __builtin_amdgcn_cvt_pk_fp8_f32(clamp8(v[4]), clamp8(v[5]), w1, false); w1 = __builtin_amdgcn_cvt_pk_fp8_f32(clamp8(v[6]), clamp8(v[7]), w1, true);
    return (u32x2){w0, w1};
}
__device__ __forceinline__ u32x2 pack8_i8(const float (&v)[8]) {
    int q[8];
#pragma unroll
    for (int e = 0; e < 8; ++e) { q[e] = (int)__builtin_rintf(v[e]); q[e] = q[e] < -127 ? -127 : (q[e] > 127 ? 127 : q[e]); }
    return (u32x2){(unsigned)(q[0] & 255) | ((unsigned)(q[1] & 255) << 8) | ((unsigned)(q[2] & 255) << 16) | ((unsigned)q[3] << 24),
                   (unsigned)(q[4] & 255) | ((unsigned)(q[5] & 255) << 8) | ((unsigned)(q[6] & 255) << 16) | ((unsigned)q[7] << 24)};
}
__device__ __forceinline__ float sigmoidf_(float x) { return __builtin_amdgcn_rcpf(1.f + __builtin_amdgcn_exp2f(-x * LOG2E)); }
__device__ __forceinline__ float shflx(float v, int o, int lane) { return __builtin_bit_cast(float, __builtin_amdgcn_ds_bpermute((lane ^ o) << 2, __builtin_bit_cast(int, v))); }
__device__ __forceinline__ float wave_sum(float v, int lane) {
#pragma unroll
    for (int o = 1; o < 64; o <<= 1) v += shflx(v, o, lane);
    return v;
}
#define LDS_WAIT() asm volatile("s_waitcnt lgkmcnt(0)" ::: "memory")
#define VM_WAIT() asm volatile("s_waitcnt vmcnt(0)" ::: "memory")

#define XB_TMO      128
#define XB_XCNT(j)  (256  + 64 * (j))
#define XB_XSUB(j)  (1280 + 64 * (j))
#define XB_XGEN(j)  (2304 + 64 * (j))
#define XB_TOP      3328
#define XB_TOPGEN   3392
#define XCD_BAR_WORDS 3456
#define XB_SPIN_CAP (1u << 20)
__device__ __forceinline__ unsigned xb_ld(unsigned* p)              { return __hip_atomic_load((GAS unsigned*)p, __ATOMIC_RELAXED, __HIP_MEMORY_SCOPE_AGENT); }
__device__ __forceinline__ unsigned xb_add(unsigned* p, unsigned v) { return __hip_atomic_fetch_add((GAS unsigned*)p, v, __ATOMIC_RELAXED, __HIP_MEMORY_SCOPE_AGENT); }
__device__ __forceinline__ unsigned xb_xcc_id() { return (unsigned)__builtin_amdgcn_s_getreg((3 << 11) | 20) & 0xFu; }
#define XB_SPIN(cond, bar) do { unsigned _sp = 0; while (cond) { __builtin_amdgcn_s_sleep(1); \
    if ((++_sp & 255u) == 0u) { if (xb_ld(&(bar)[XB_TMO])) break; if (_sp > XB_SPIN_CAP) { xb_add(&(bar)[XB_TMO], 1u); break; } } } } while (0)
struct XcdBarrier { unsigned* bar; unsigned x; volatile LAS unsigned* st; };
__device__ __forceinline__ XcdBarrier xcd_barrier_post(unsigned* bar, volatile LAS unsigned* st) {
    XcdBarrier b; b.bar = bar; b.x = xb_xcc_id(); b.st = st;
    if (threadIdx.x == 0) (void)xb_add(&as_global(bar)[XB_XCNT(b.x)], 1u);
    return b;
}
__device__ __forceinline__ void xcd_barrier_complete(unsigned* bar, unsigned x, unsigned& nloc, unsigned& nx) {
    const unsigned G = gridDim.x * gridDim.y * gridDim.z;
    unsigned sum, cnt, mine, sp = 0u;
    for (;;) {
        sum = 0u; cnt = 0u; mine = 0u;
#pragma unroll
        for (unsigned j = 0; j < 16; ++j) { const unsigned c = xb_ld(&bar[XB_XCNT(j)]); sum += c; cnt += (c > 0u) ? 1u : 0u; mine = (j == x) ? c : mine; }
        if (sum == G) break;
        __builtin_amdgcn_s_sleep(1);
        if ((++sp & 255u) == 0u) { if (xb_ld(&bar[XB_TMO])) break; if (sp > XB_SPIN_CAP) { xb_add(&bar[XB_TMO], 1u); break; } }
    }
    nloc = mine > 0u ? mine : 1u; nx = cnt > 0u ? cnt : 1u;
}
__device__ __forceinline__ void xcd_barrier(const XcdBarrier& b) {
    asm volatile("s_waitcnt vmcnt(0)" ::: "memory");
    __syncthreads();
    if (threadIdx.x == 0) {
        unsigned* bar = as_global(b.bar);
        __builtin_amdgcn_s_waitcnt(0);
        unsigned nloc = b.st[0], nx = b.st[1];
        if (nloc == 0u) { xcd_barrier_complete(bar, b.x, nloc, nx); b.st[0] = nloc; b.st[1] = nx; }
        const unsigned old = xb_add(&bar[XB_XSUB(b.x)], 1u);
        const unsigned gen = old / nloc;
        if (old + 1u == (gen + 1u) * nloc) {
            __builtin_amdgcn_fence(__ATOMIC_RELEASE, "agent");
            asm volatile("s_waitcnt vmcnt(0)" ::: "memory");
            const unsigned og = xb_add(&bar[XB_TOP], 1u);
            const unsigned tg = og / nx;
            if (og + 1u == (tg + 1u) * nx) xb_add(&bar[XB_TOPGEN], 1u);
            else XB_SPIN(xb_ld(&bar[XB_TOPGEN]) == tg, bar);
            __builtin_amdgcn_fence(__ATOMIC_ACQUIRE, "agent");
            xb_add(&bar[XB_XGEN(b.x)], 1u);
            asm volatile("s_waitcnt vmcnt(0)" ::: "memory");
        } else {
            XB_SPIN(xb_ld(&bar[XB_XGEN(b.x)]) == gen, bar);
            __builtin_amdgcn_fence(__ATOMIC_ACQUIRE, "agent");
            asm volatile("s_waitcnt vmcnt(0)" ::: "memory");
        }
    }
    __syncthreads();
}

namespace pg8 {
constexpr int BM = 256, BK = 64, HALF = 128, HTB = HALF * BK * 2;
__device__ __forceinline__ int lds_byte(int r, int c) { const int st = (r >> 4) * 2 + (c >> 5), rr = r & 15, cc = c & 31, ob = rr * 64 + cc * 2; return st * 1024 + (ob ^ (((ob >> 9) & 1) << 5)); }
__device__ __forceinline__ void stage_rc(int b, int& R, int& C) { const int st = b / 1024, sb = b % 1024, swz = sb ^ (((sb >> 9) & 1) << 5); R = (st >> 1) * 16 + swz / 64; C = (st & 1) * 32 + (swz % 64) / 2; }
__device__ __forceinline__ int perm32(int rho) { const int n = rho >> 4, i = rho & 15; return 8 * (i >> 2) + 4 * n + (i & 3); }

struct Unit { int pm, pn, g; };
struct Sched {
    const char* A; const char* B; int ldaB, kB, nMv, nN, G, c, skipctx, npg, acolstep; const LAS int* ts; size_t bgstride; int nextra;
    __device__ __forceinline__ bool next(int i, Unit& u) const {
        const int nmain = nMv * nN, nwg = nmain + nextra; const long L = (long)i * G + c; if (L >= nwg) return false;
        int wgid = (int)L; { const int q = nwg / 8, r = nwg % 8, xcd = wgid % 8, off = wgid / 8; wgid = (xcd < r ? xcd * (q + 1) : r * (q + 1) + (xcd - r) * q) + off; }
        if (wgid >= nmain) { const int e = wgid - nmain, j = e & 15; u.pm = 9 * (e >> 4); u.pn = j < 8 ? 4 + j : (j < 14 ? 6 + j : 14 + j); u.g = 0; return true; }
        const int nig = 8 * nN, gid = wgid / nig, fm = gid * 8, gsz = (nMv - fm) < 8 ? (nMv - fm) : 8;
        const int pmv = fm + ((wgid % nig) % gsz); u.pn = (wgid % nig) / gsz;
        u.pm = skipctx ? pmv + (pmv >> 3) + 1 : pmv;
        int g = 0;
        if (ts) {
#pragma unroll
            for (int e = 1; e < 8; ++e) g += (pmv >= ts[e]) ? 1 : 0; }
        u.g = g; return true;
    }
    __device__ __forceinline__ const char* Aptr(const Unit& u) const { return A + (size_t)u.pm * 256 * ldaB + (size_t)(u.pn / npg) * acolstep; }
    __device__ __forceinline__ const char* Bptr(const Unit& u) const { return B + (size_t)u.g * bgstride + (size_t)u.pn * 256 * kB; }
};

typedef f32x4 Acc[2][2][4][2];
typedef int v8i __attribute__((ext_vector_type(8)));
typedef int v4i __attribute__((ext_vector_type(4)));

template <bool I8> __device__ __forceinline__ f32x4 accval(const f32x4& a, const f32x4& sc) { if constexpr (I8) return __builtin_convertvector(__builtin_bit_cast(v4i, a), f32x4) * sc; else return a * sc; }
template <bool I8> struct EpiStore {   static constexpr int NSTORES = 16;
    bf16* O; int ldc; const float* rowscale; float scale; const float* sa; const float* sw;
    __device__ __forceinline__ void operator()(const Acc& acc, const Unit& u, int wr, int wc, int fr, int fq) const {
        const int row0 = u.pm * BM + wr * 64 + fr, col0 = u.pn * BM + wc * 32 + 8 * fq;
        f32x4 cs[2][2];
#pragma unroll
        for (int bj = 0; bj < 2; ++bj)
#pragma unroll
            for (int n = 0; n < 2; ++n) cs[bj][n] = I8 ? *(const f32x4*)(sw + col0 + bj * HALF + 4 * n) : (f32x4){1.f, 1.f, 1.f, 1.f};
        float rs_[8];
#pragma unroll
        for (int i = 0; i < 8; ++i) { const int row = row0 + (i >> 2) * HALF + (i & 3) * 16; rs_[i] = I8 ? sa[row] : (rowscale ? rowscale[row] * scale : scale); }
        asm volatile("" : "+v"(rs_[0]), "+v"(rs_[1]), "+v"(rs_[2]), "+v"(rs_[3]), "+v"(rs_[4]), "+v"(rs_[5]), "+v"(rs_[6]), "+v"(rs_[7]));
#pragma unroll
        for (int ai = 0; ai < 2; ++ai)
#pragma unroll
            for (int m = 0; m < 4; ++m) { const int row = row0 + ai * HALF + m * 16; const float s = rs_[ai * 4 + m]; bf16* rowp = O + (size_t)row * ldc + col0;
#pragma unroll
                for (int bj = 0; bj < 2; ++bj) { const f32x4 v0 = accval<I8>(acc[ai][bj][m][0], cs[bj][0]) * s, v1 = accval<I8>(acc[ai][bj][m][1], cs[bj][1]) * s;
                    u32x4 w; w.x = cvt_pk_bf16(v0[0], v0[1]); w.y = cvt_pk_bf16(v0[2], v0[3]); w.z = cvt_pk_bf16(v1[0], v1[1]); w.w = cvt_pk_bf16(v1[2], v1[3]);
                    *(u32x4*)(rowp + bj * HALF) = w; } }
    }
};
template <bool I8> struct EpiG2 {      static constexpr int NSTORES = 16;
    bf16* Y2; const bf16* BB; const float* sa; const float* sw;
    __device__ __forceinline__ void operator()(const Acc& acc, const Unit& u, int wr, int wc, int fr, int fq) const {
        const int row0 = u.pm * BM + wr * 64 + fr, col0 = u.pn * BM + wc * 32 + 8 * fq;
        f32x4 cs[2][2];
#pragma unroll
        for (int bj = 0; bj < 2; ++bj)
#pragma unroll
            for (int n = 0; n < 2; ++n) cs[bj][n] = I8 ? *(const f32x4*)(sw + col0 + bj * HALF + 4 * n) : (f32x4){1.f, 1.f, 1.f, 1.f};
        float rs_[8];
#pragma unroll
        for (int i = 0; i < 8; ++i) { const int row = row0 + (i >> 2) * HALF + (i & 3) * 16; rs_[i] = I8 ? sa[row] : 1.f; }
        asm volatile("" : "+v"(rs_[0]), "+v"(rs_[1]), "+v"(rs_[2]), "+v"(rs_[3]), "+v"(rs_[4]), "+v"(rs_[5]), "+v"(rs_[6]), "+v"(rs_[7]));
#pragma unroll
        for (int ai = 0; ai < 2; ++ai) {
            u32x4 bv[4][2];
#pragma unroll
            for (int m = 0; m < 4; ++m)
#pragma unroll
                for (int bj = 0; bj < 2; ++bj) bv[m][bj] = *(const u32x4*)(BB + (size_t)(row0 + ai * HALF + m * 16) * 6144 + 4096 + col0 + bj * HALF);
            asm volatile("" : "+v"(bv[0][0]), "+v"(bv[0][1]), "+v"(bv[1][0]), "+v"(bv[1][1]), "+v"(bv[2][0]), "+v"(bv[2][1]), "+v"(bv[3][0]), "+v"(bv[3][1]));
#pragma unroll
            for (int m = 0; m < 4; ++m) { const int row = row0 + ai * HALF + m * 16; const float ra = rs_[ai * 4 + m];
#pragma unroll
                for (int bj = 0; bj < 2; ++bj) { const int col = col0 + bj * HALF;
                    float b[8]; unpack8(bv[m][bj], b);
                    const f32x4 a0 = accval<I8>(acc[ai][bj][m][0], cs[bj][0]) * ra, a1 = accval<I8>(acc[ai][bj][m][1], cs[bj][1]) * ra; float o[8];
#pragma unroll
                    for (int j = 0; j < 4; ++j) { o[j] = sigmoidf_(a0[j]) * b[j]; o[4 + j] = sigmoidf_(a1[j]) * b[4 + j]; }
                    *(u32x4*)(Y2 + (size_t)row * 2048 + col) = pack8(o); } } }
    }
};
template <bool I8> struct EpiG01 {     static constexpr int NSTORES = 8;
    bf16* Y; const bf16* Y2; const bf16* BB; int m0, m1, m2; const float* sa; const float* sw;
    __device__ __forceinline__ void operator()(const Acc& acc, const Unit& u, int wr, int wc, int fr, int fq) const {
        const int row0 = u.pm * BM + wr * 64 + fr, col = u.pn * HALF + wc * 32 + 8 * fq, bcol = u.pn * BM + wc * 32 + 8 * fq;
        f32x4 cs[2][2];
#pragma unroll
        for (int bj = 0; bj < 2; ++bj)
#pragma unroll
            for (int n = 0; n < 2; ++n) cs[bj][n] = I8 ? *(const f32x4*)(sw + bcol + bj * HALF + 4 * n) : (f32x4){1.f, 1.f, 1.f, 1.f};
        float rs_[8];
#pragma unroll
        for (int i = 0; i < 8; ++i) { const int row = row0 + (i >> 2) * HALF + (i & 3) * 16; rs_[i] = I8 ? sa[row] : 1.f; }
        asm volatile("" : "+v"(rs_[0]), "+v"(rs_[1]), "+v"(rs_[2]), "+v"(rs_[3]), "+v"(rs_[4]), "+v"(rs_[5]), "+v"(rs_[6]), "+v"(rs_[7]));
#pragma unroll
        for (int ai = 0; ai < 2; ++ai) {
            u32x4 yv[4], b0v[4], b1v[4];
#pragma unroll
            for (int m = 0; m < 4; ++m) { const size_t row = (size_t)(row0 + ai * HALF + m * 16);
                yv[m] = *(const u32x4*)(Y2 + row * 2048 + col); b0v[m] = *(const u32x4*)(BB + row * 6144 + col); b1v[m] = *(const u32x4*)(BB + row * 6144 + 2048 + col); }
            asm volatile("" : "+v"(yv[0]), "+v"(yv[1]), "+v"(yv[2]), "+v"(yv[3]), "+v"(b0v[0]), "+v"(b0v[1]), "+v"(b0v[2]), "+v"(b0v[3]), "+v"(b1v[0]), "+v"(b1v[1]), "+v"(b1v[2]), "+v"(b1v[3]));
#pragma unroll
            for (int m = 0; m < 4; ++m) { const int row = row0 + ai * HALF + m * 16; const float ra = rs_[ai * 4 + m];
                float y2[8], b0[8], b1[8], o[8];
                unpack8(yv[m], y2); unpack8(b0v[m], b0); unpack8(b1v[m], b1);
                const f32x4 g00 = accval<I8>(acc[ai][0][m][0], cs[0][0]) * ra, g01 = accval<I8>(acc[ai][0][m][1], cs[0][1]) * ra, g10 = accval<I8>(acc[ai][1][m][0], cs[1][0]) * ra, g11 = accval<I8>(acc[ai][1][m][1], cs[1][1]) * ra;
#pragma unroll
                for (int j = 0; j < 4; ++j) {
                    o[j] = (m2 ? y2[j] : 0.f) + (m0 ? sigmoidf_(g00[j]) * b0[j] : 0.f) + (m1 ? sigmoidf_(g10[j]) * b1[j] : 0.f);
                    o[4 + j] = (m2 ? y2[4 + j] : 0.f) + (m0 ? sigmoidf_(g01[j]) * b0[4 + j] : 0.f) + (m1 ? sigmoidf_(g11[j]) * b1[4 + j] : 0.f); }
                *(u32x4*)(Y + (size_t)row * 2048 + col) = pack8(o); } }
    }
};
template <bool FP8OUT, bool INT8IN> struct EpiSwiGLU {
    static constexpr bool WIDE = false; static constexpr int NSTORES = 8;
    void* ACTv; float scale; const float* sa; const float* sw;
    __device__ __forceinline__ void operator()(const Acc& acc, const Unit& u, int wr, int wc, int fr, int fq) const {
        const int row0 = u.pm * BM + wr * 64 + fr, col = u.pn * HALF + wc * 32 + 8 * fq, bcol = u.pn * BM + wc * 32 + 8 * fq;
        f32x4 sg0 = {scale, scale, scale, scale}, sg1 = sg0, su0 = sg0, su1 = sg0;
        if constexpr (INT8IN) { sg0 = *(const f32x4*)(sw + bcol); sg1 = *(const f32x4*)(sw + bcol + 4); su0 = *(const f32x4*)(sw + bcol + HALF); su1 = *(const f32x4*)(sw + bcol + HALF + 4); }
        float rs_[8];
#pragma unroll
        for (int i = 0; i < 8; ++i) { const int row = row0 + (i >> 2) * HALF + (i & 3) * 16; rs_[i] = INT8IN ? sa[row] : 1.f; }
        asm volatile("" : "+v"(rs_[0]), "+v"(rs_[1]), "+v"(rs_[2]), "+v"(rs_[3]), "+v"(rs_[4]), "+v"(rs_[5]), "+v"(rs_[6]), "+v"(rs_[7]));
#pragma unroll
        for (int ai = 0; ai < 2; ++ai)
#pragma unroll
            for (int m = 0; m < 4; ++m) { const int row = row0 + ai * HALF + m * 16; float o[8];
                f32x4 g0, g1, u0, u1;
                if constexpr (INT8IN) { const float ra = rs_[ai * 4 + m];
                    g0 = __builtin_convertvector(__builtin_bit_cast(v4i, acc[ai][0][m][0]), f32x4) * sg0 * ra; g1 = __builtin_convertvector(__builtin_bit_cast(v4i, acc[ai][0][m][1]), f32x4) * sg1 * ra;
                    u0 = __builtin_convertvector(__builtin_bit_cast(v4i, acc[ai][1][m][0]), f32x4) * su0 * ra; u1 = __builtin_convertvector(__builtin_bit_cast(v4i, acc[ai][1][m][1]), f32x4) * su1 * ra; }
                else { g0 = acc[ai][0][m][0] * sg0; g1 = acc[ai][0][m][1] * sg1; u0 = acc[ai][1][m][0] * su0; u1 = acc[ai][1][m][1] * su1; }
#pragma unroll
                for (int j = 0; j < 4; ++j) { o[j] = g0[j] * sigmoidf_(g0[j]) * u0[j]; o[4 + j] = g1[j] * sigmoidf_(g1[j]) * u1[j]; }
                if constexpr (FP8OUT) *(u32x2*)((unsigned char*)ACTv + (size_t)row * FF + col) = pack8_fp8(o);
                else *(u32x4*)((bf16*)ACTv + (size_t)row * FF + col) = pack8(o); }
    }
};

template <class Epi, int KIND>
__device__ __forceinline__ void gemm_phase(LAS unsigned char* lds, const Sched& S, const Epi& E, const int tid) {
    const int wid = __builtin_amdgcn_readfirstlane(tid >> 6), lane = tid & 63, wr = wid >> 2, wc = wid & 3, fr = lane & 15, fq = lane >> 4;
    const int kB = S.kB, nt = kB / 128;
    unsigned voffA[2], voffB[2];
#pragma unroll
    for (int i = 0; i < 2; ++i) { int R, C; stage_rc(tid * 16 + i * 8192, R, C); const int Rb = (R & ~31) + perm32(R & 31);
        voffA[i] = (unsigned)(R * S.ldaB + 2 * C); voffB[i] = (unsigned)(Rb * kB + 2 * C); }
    const size_t kstep = (size_t)(BK * 2);
    const size_t hstepA = (size_t)HALF * S.ldaB, hstepB = (size_t)HALF * kB;
    const unsigned ldsw = (unsigned)wid * 1024u;
    const int aoff = lds_byte(wr * 64 + fr, fq * 8), boff = lds_byte(wc * 32 + fr, fq * 8);
#define PG8_SA(b, h) (((b) * 2 + (h)) * HTB)
#define PG8_SB(b, h) ((4 + (b) * 2 + (h)) * HTB)
#define PG8_STAGE(bufoff, gbase, voff) do { _Pragma("unroll") for (int _i = 0; _i < 2; ++_i) \
        __builtin_amdgcn_global_load_lds((const unsigned*)((const char*)(gbase) + (voff)[_i]), (LAS unsigned*)(lds + (bufoff) + ldsw + _i * 8192), 16, 0, 0); } while (0)
#define PG8_LD8(p) __builtin_shufflevector(*(const LAS v4i*)(p), *(const LAS v4i*)((p) + 1024), 0, 1, 2, 3, 4, 5, 6, 7)
#define PG8_LDA(dst, b, h) do { _Pragma("unroll") for (int m = 0; m < 4; ++m) dst[m] = PG8_LD8(lds + PG8_SA(b, h) + aoff + m * 2048); } while (0)
#define PG8_LDB(dst, b, h) do { _Pragma("unroll") for (int n = 0; n < 2; ++n) dst[n] = PG8_LD8(lds + PG8_SB(b, h) + boff + n * 2048); } while (0)
#define PG8_HALF(X, k) __builtin_bit_cast(bf16x8, __builtin_shufflevector(X, X, 4 * (k), 4 * (k) + 1, 4 * (k) + 2, 4 * (k) + 3))
#define PG8_MMA(ai, bj, At, Bt) do { __builtin_amdgcn_s_setprio(1); _Pragma("unroll") for (int m = 0; m < 4; ++m) _Pragma("unroll") for (int n = 0; n < 2; ++n) { \
        if constexpr (KIND == 1) asm volatile("v_mfma_f32_16x16x128_f8f6f4 %0, %1, %2, %0" : "+v"(acc[ai][bj][m][n]) : "v"(Bt[n]), "v"(At[m]));     \
        else if constexpr (KIND == 2) { acc[ai][bj][m][n] = __builtin_bit_cast(f32x4, __builtin_amdgcn_mfma_i32_16x16x64_i8(__builtin_bit_cast(v4i, PG8_HALF(Bt[n], 0)), __builtin_bit_cast(v4i, PG8_HALF(At[m], 0)), __builtin_bit_cast(v4i, acc[ai][bj][m][n]), 0, 0, 0)); \
               acc[ai][bj][m][n] = __builtin_bit_cast(f32x4, __builtin_amdgcn_mfma_i32_16x16x64_i8(__builtin_bit_cast(v4i, PG8_HALF(Bt[n], 1)), __builtin_bit_cast(v4i, PG8_HALF(At[m], 1)), __builtin_bit_cast(v4i, acc[ai][bj][m][n]), 0, 0, 0)); } \
        else { acc[ai][bj][m][n] = __builtin_amdgcn_mfma_f32_16x16x32_bf16(PG8_HALF(Bt[n], 0), PG8_HALF(At[m], 0), acc[ai][bj][m][n], 0, 0, 0); \
               acc[ai][bj][m][n] = __builtin_amdgcn_mfma_f32_16x16x32_bf16(PG8_HALF(Bt[n], 1), PG8_HALF(At[m], 1), acc[ai][bj][m][n], 0, 0, 0); } } __builtin_amdgcn_s_setprio(0); } while (0)
#define PG8_WAIT_V(n) asm volatile("s_waitcnt vmcnt(" #n ")" ::: "memory")
#define PG8_WAIT_VI(n) asm volatile("s_waitcnt vmcnt(%0)" :: "n"(n) : "memory")
#define PG8_WAIT_L(n) asm volatile("s_waitcnt lgkmcnt(" #n ")" ::: "memory")
#define PG8_BAR __builtin_amdgcn_s_barrier()
#define PG8_SCHED __builtin_amdgcn_sched_barrier(0)
    Unit cur, nxt; int ui = 0;
    if (!S.next(0, cur)) return;
    Acc acc;
#pragma unroll
    for (int a = 0; a < 2; ++a)
#pragma unroll
        for (int b = 0; b < 2; ++b)
#pragma unroll
            for (int m = 0; m < 4; ++m)
#pragma unroll
                for (int n = 0; n < 2; ++n) acc[a][b][m][n] = (f32x4){0.f, 0.f, 0.f, 0.f};
    v8i At[4], B0[2], B1[2];
    const char* cA = S.Aptr(cur); const char* cB = S.Bptr(cur);
    PG8_STAGE(PG8_SB(0, 0), cB, voffB); PG8_STAGE(PG8_SB(0, 1), cB + hstepB, voffB); PG8_STAGE(PG8_SA(0, 0), cA, voffA); PG8_STAGE(PG8_SA(0, 1), cA + hstepA, voffA);
    if (wr == 1) PG8_BAR;
    PG8_WAIT_V(2); PG8_BAR;
    PG8_STAGE(PG8_SB(1, 0), cB + kstep, voffB); PG8_STAGE(PG8_SB(1, 1), cB + hstepB + kstep, voffB); PG8_STAGE(PG8_SA(1, 0), cA + kstep, voffA); PG8_STAGE(PG8_SA(1, 1), cA + kstep + hstepA, voffA);
    PG8_WAIT_V(8); PG8_BAR;
    constexpr int NS = Epi::NSTORES;
    for (;;) {
        const bool has_next = S.next(ui + 1, nxt);
        const char* nA = has_next ? S.Aptr(nxt) : cA; const char* nB = has_next ? S.Bptr(nxt) : cB;
#define PG8_ITER(W1, W2, W3) { const bool last = (t == nt - 2);                                                                                                         \
            const char* a2 = last ? nA : cA + (size_t)(t + 2) * kstep; const char* b2 = last ? nB : cB + (size_t)(t + 2) * kstep;                                        \
            const char* b3 = b2 + kstep; const char* a3 = a2 + kstep;                                                                                                    \
            PG8_LDB(B0, 0, 0); PG8_LDB(B1, 0, 1); PG8_SCHED; PG8_LDA(At, 0, 0);                                                                                          \
            if (t == 0 && ui > 0) PG8_WAIT_VI(NS + W1); else PG8_WAIT_VI(W1); PG8_WAIT_L(0); PG8_BAR; PG8_MMA(0, 0, At, B0); PG8_MMA(0, 1, At, B1); PG8_BAR; PG8_SCHED;                                                   \
            PG8_LDA(At, 0, 1); PG8_STAGE(PG8_SB(0, 0), b2, voffB); PG8_STAGE(PG8_SB(0, 1), b2 + hstepB, voffB);                                                          \
            if (t == 0 && ui > 0) PG8_WAIT_VI(NS + W2); else PG8_WAIT_VI(W2); PG8_WAIT_L(0); PG8_BAR; PG8_MMA(1, 0, At, B0); PG8_MMA(1, 1, At, B1); PG8_BAR; PG8_SCHED;                                                   \
            PG8_LDB(B0, 1, 0); PG8_LDB(B1, 1, 1); PG8_SCHED; PG8_LDA(At, 1, 0); PG8_STAGE(PG8_SA(0, 0), a2, voffA); PG8_STAGE(PG8_SA(0, 1), a2 + hstepA, voffA);         \
            if (t == 0 && ui > 0) PG8_WAIT_VI(NS + W3); else PG8_WAIT_VI(W3); PG8_WAIT_L(0); PG8_BAR; PG8_MMA(0, 0, At, B0); PG8_MMA(0, 1, At, B1); PG8_BAR; PG8_SCHED;                                                   \
            PG8_LDA(At, 1, 1); PG8_STAGE(PG8_SB(1, 0), b3, voffB); PG8_STAGE(PG8_SB(1, 1), b3 + hstepB, voffB);                                                          \
            PG8_WAIT_V(6); PG8_WAIT_L(0); PG8_BAR; PG8_MMA(1, 0, At, B0); PG8_MMA(1, 1, At, B1); PG8_BAR; PG8_SCHED;                                                     \
            PG8_STAGE(PG8_SA(1, 0), a3, voffA); PG8_STAGE(PG8_SA(1, 1), a3 + hstepA, voffA); PG8_SCHED; }
        for (int t = 0; t < nt; t += 2) PG8_ITER(8, 6, 8)
#undef PG8_ITER
        if (wr == 0) PG8_BAR;
        if constexpr (KIND == 1) asm volatile("s_nop 15\n\ts_nop 15" ::: "memory");
        {
            int ln_e; asm volatile("v_mbcnt_lo_u32_b32 %0, -1, 0\n\tv_mbcnt_hi_u32_b32 %0, -1, %0" : "=v"(ln_e));
            E(acc, cur, wr, wc, ln_e & 15, ln_e >> 4); }
        if (!has_next) break;
#pragma unroll
        for (int a = 0; a < 2; ++a)
#pragma unroll
            for (int b = 0; b < 2; ++b)
#pragma unroll
                for (int m = 0; m < 4; ++m)
#pragma unroll
                    for (int n = 0; n < 2; ++n) acc[a][b][m][n] = (f32x4){0.f, 0.f, 0.f, 0.f};
        cur = nxt; cA = nA; cB = nB; ++ui;
        if (wr == 1) PG8_BAR;
    }
    PG8_WAIT_V(0);
    PG8_BAR;
#undef PG8_SA
#undef PG8_SB
#undef PG8_STAGE
#undef PG8_LDA
#undef PG8_LDB
#undef PG8_MMA
#undef PG8_HALF
#undef PG8_LD8
#undef PG8_WAIT_V
#undef PG8_WAIT_VI
#undef PG8_WAIT_L
#undef PG8_BAR
#undef PG8_SCHED
}
}

namespace att {
constexpr int LDP = WIN;
constexpr int SHM_V = 64 * 128 * 2, SHM_K = 64 * 128 * 2;
constexpr int SHM_ATTN = 2 * SHM_V + 2 * SHM_K + 8 * 64 * 4;
#define KSWZ(row, colB) ((row) * 256 + ((colB) ^ (((row) & 7) << 4)))
#define SBAR() __builtin_amdgcn_sched_barrier(0)
__device__ __forceinline__ int crow(int r, int hi) { return (r & 3) + 8 * (r >> 2) + 4 * hi; }
__device__ __forceinline__ int v_st(int k, int c) { const int kk = (k & ~0xC) | ((k & 4) << 1) | ((k & 8) >> 1); return ((kk >> 3) * 4 + (c >> 5)) * 512 + ((kk & 7) * 32 + (c & 31)) * 2; }
__device__ __forceinline__ int v_rd_base(int lane) { return ((lane & 3) << 3) | (((lane >> 2) & 3) << 6) | (((lane >> 4) & 1) << 5) | (((lane >> 5) & 1) << 8); }
constexpr int v_rd_off(int d0, int ks, int half) { return d0 * 512 + ks * 4096 + half * 2048; }
template <int OFF> __device__ __forceinline__ s16x4 tr_read(int vb) {
    s16x4 r; asm volatile("ds_read_b64_tr_b16 %0, %1 offset:%2" : "=&v"(r) : "v"(vb), "i"(OFF) : "memory"); return r;
}
template <int D0> __device__ __forceinline__ void pv_one(f32x16& od, int vb, bf16x8 pa0, bf16x8 pa1, bf16x8 pa2, bf16x8 pa3) {
    const s16x4 l0 = tr_read<v_rd_off(D0, 0, 0)>(vb), h0 = tr_read<v_rd_off(D0, 0, 1)>(vb), l1 = tr_read<v_rd_off(D0, 1, 0)>(vb), h1 = tr_read<v_rd_off(D0, 1, 1)>(vb);
    const s16x4 l2 = tr_read<v_rd_off(D0, 2, 0)>(vb), h2 = tr_read<v_rd_off(D0, 2, 1)>(vb), l3 = tr_read<v_rd_off(D0, 3, 0)>(vb), h3 = tr_read<v_rd_off(D0, 3, 1)>(vb);
    asm volatile("s_waitcnt lgkmcnt(0)" ::: "memory"); SBAR();
#define PK(L, H) (bf16x8){L[0], L[1], L[2], L[3], H[0], H[1], H[2], H[3]}
    od = __builtin_amdgcn_mfma_f32_32x32x16_bf16(pa0, PK(l0, h0), od, 0, 0, 0);
    od = __builtin_amdgcn_mfma_f32_32x32x16_bf16(pa1, PK(l1, h1), od, 0, 0, 0);
    od = __builtin_amdgcn_mfma_f32_32x32x16_bf16(pa2, PK(l2, h2), od, 0, 0, 0);
    od = __builtin_amdgcn_mfma_f32_32x32x16_bf16(pa3, PK(l3, h3), od, 0, 0, 0);
#undef PK
}
__device__ __forceinline__ void pv_d0(f32x16* o, int vb, bf16x8 pa0, bf16x8 pa1, bf16x8 pa2, bf16x8 pa3) {
    pv_one<0>(o[0], vb, pa0, pa1, pa2, pa3); pv_one<1>(o[1], vb, pa0, pa1, pa2, pa3); pv_one<2>(o[2], vb, pa0, pa1, pa2, pa3); pv_one<3>(o[3], vb, pa0, pa1, pa2, pa3);
}
__device__ __forceinline__ void partialSM(f32x16& p0, f32x16& p1, float& m_reg, float& mn, float& alpha, float C, float thr) {
    float pmax = p0[0];
#pragma unroll
    for (int r = 1; r < 16; ++r) pmax = fmaxf(pmax, p0[r]);
#pragma unroll
    for (int r = 0; r < 16; ++r) pmax = fmaxf(pmax, p1[r]);
    { auto rr = __builtin_amdgcn_permlane32_swap(__float_as_uint(pmax), __float_as_uint(pmax), false, false);
      pmax = fmaxf(__uint_as_float(rr[0]), __uint_as_float(rr[1])); }
    if (__builtin_expect(__all(pmax - m_reg <= thr), 1)) { mn = m_reg; alpha = 1.f; }
    else { mn = fmaxf(m_reg, pmax); alpha = __builtin_amdgcn_exp2f((m_reg - mn) * C); m_reg = mn; }
    const float mnC = -mn * C;
#pragma unroll
    for (int r = 0; r < 16; ++r) p0[r] = fmaf(p0[r], C, mnC);
#pragma unroll
    for (int r = 0; r < 16; ++r) p1[r] = fmaf(p1[r], C, mnC);
#pragma unroll
    for (int r = 0; r < 16; ++r) p0[r] = __builtin_amdgcn_exp2f(p0[r]);
}
#define PK4(P, BASE, OUT) do { unsigned a0 = cvt_pk_bf16(P[BASE + 0], P[BASE + 1]), a1 = cvt_pk_bf16(P[BASE + 2], P[BASE + 3]);   \
    unsigned b0 = cvt_pk_bf16(P[BASE + 4], P[BASE + 5]), b1 = cvt_pk_bf16(P[BASE + 6], P[BASE + 7]);                              \
    auto r0 = __builtin_amdgcn_permlane32_swap(a0, b0, false, false); auto r1 = __builtin_amdgcn_permlane32_swap(a1, b1, false, false); \
    u32x4 w = {r0[0], r1[0], r0[1], r1[1]}; OUT = __builtin_bit_cast(bf16x8, w); } while (0)
__device__ __forceinline__ void finishSM(f32x16& p0, f32x16& p1, float alpha, float& l_reg, bf16x8& pa0, bf16x8& pa1, bf16x8& pa2, bf16x8& pa3) {
#pragma unroll
    for (int r = 0; r < 16; ++r) p1[r] = __builtin_amdgcn_exp2f(p1[r]);
    float ps = 0;
#pragma unroll
    for (int r = 0; r < 16; ++r) ps += p0[r];
#pragma unroll
    for (int r = 0; r < 16; ++r) ps += p1[r];
    { auto rr = __builtin_amdgcn_permlane32_swap(__float_as_uint(ps), __float_as_uint(ps), false, false);
      ps = __uint_as_float(rr[0]) + __uint_as_float(rr[1]); }
    l_reg = l_reg * alpha + ps;
    PK4(p0, 0, pa0); PK4(p0, 8, pa1); PK4(p1, 0, pa2); PK4(p1, 8, pa3);
}
__device__ __forceinline__ void packP(f32x16& p0, f32x16& p1, bf16x8& pa0, bf16x8& pa1, bf16x8& pa2, bf16x8& pa3) {
    PK4(p0, 0, pa0); PK4(p0, 8, pa1); PK4(p1, 0, pa2); PK4(p1, 8, pa3);
}
struct RetP { float lf2, lb2, lrs; int qs0, latq; };
template <bool EXTRA> __device__ __forceinline__ void retP(f32x16& p0, f32x16& p1, int qs, int ks0, int hi, const RetP& rp) {
    const float dbase = (float)(qs - ks0 - 4 * hi), ebase = (float)(TPB - qs + ks0 + 4 * hi), nlb2 = -rp.lb2;
#pragma unroll
    for (int r = 0; r < 16; ++r) {
        const float cr = (float)((r & 3) + 8 * (r >> 2));
        const float d0 = dbase - cr, d1 = d0 - 32.f;
        float f0 = __builtin_amdgcn_exp2f(fmaf(d0 > 0.f ? rp.lf2 : nlb2, d0, rp.lrs)), f1 = __builtin_amdgcn_exp2f(fmaf(d1 > 0.f ? rp.lf2 : nlb2, d1, rp.lrs));
        f0 = (d0 == 0.f) ? f0 + f0 : f0; f1 = (d1 == 0.f) ? f1 + f1 : f1;
        if (EXTRA) { f0 += __builtin_amdgcn_exp2f(fmaf(rp.lb2, ebase + cr, rp.lrs)); f1 += __builtin_amdgcn_exp2f(fmaf(rp.lb2, ebase + cr + 32.f, rp.lrs)); }
        p0[r] *= f0; p1[r] *= f1;
        if ((r & 3) == 3) __builtin_amdgcn_sched_barrier(0);
    }
}
template <int KIND> __device__ __forceinline__ void retT(f32x16& p0, f32x16& p1, float Fl, float Bl, float dbase, const LAS float* tab) {
#pragma unroll
    for (int g = 0; g < 4; ++g) {
        f32x4 tf0 = {}, tf1 = {}, tb0 = {}, tb1 = {};
        if (KIND != 2) { tf0 = *(const LAS f32x4*)(tab + 8 * g); tf1 = *(const LAS f32x4*)(tab + 32 + 8 * g); }
        if (KIND != 1) { tb0 = *(const LAS f32x4*)(tab + 64 + 8 * g); tb1 = *(const LAS f32x4*)(tab + 96 + 8 * g); }
#pragma unroll
        for (int e = 0; e < 4; ++e) { const int r = 4 * g + e; float w0, w1;
            if (KIND == 1) { w0 = Fl * tf0[e]; w1 = Fl * tf1[e]; }
            else if (KIND == 2) { w0 = Bl * tb0[e]; w1 = Bl * tb1[e]; }
            else if (KIND == 3) { w0 = fmaf(Bl, tb0[e], Fl * tf0[e]); w1 = fmaf(Bl, tb1[e], Fl * tf1[e]); }
            else { const float c0 = (float)(8 * g + e), c1 = c0 + 32.f; const float a0 = Fl * tf0[e], b0 = Bl * tb0[e], a1 = Fl * tf1[e], b1 = Bl * tb1[e];
                w0 = (c0 == dbase) ? a0 + b0 : fminf(a0, b0); w1 = (c1 == dbase) ? a1 + b1 : fminf(a1, b1); }
            p0[r] *= w0; p1[r] *= w1; }
    }
}
__device__ __forceinline__ int ret_class(int tile, int latq, int tq0) { return !latq ? 0 : (tile >= 4 && tile < tq0) ? 1 : (tile >= tq0 + 4) ? 2 : 0; }
__device__ __forceinline__ bf16x8 scale8(bf16x8 v, float f) { float x[8]; unpack8(__builtin_bit_cast(u32x4, v), x);
#pragma unroll
    for (int e = 0; e < 8; ++e) x[e] *= f;
    return __builtin_bit_cast(bf16x8, pack8(x)); }
template <int ND0> __device__ __forceinline__ void qkt(f32x16& p0, f32x16& p1, const LAS char* Ks, const bf16x8* qr, int r32, int hi, int kcolB) {
    p0 = f32x16{}; p1 = f32x16{};
#pragma unroll
    for (int d0 = 0; d0 < ND0; ++d0) { const int cb = (d0 * 16 + hi * 8) * 2;
        const bf16x8 b0 = *(const LAS bf16x8*)(Ks + KSWZ(r32, cb) + kcolB);
        const bf16x8 b1 = *(const LAS bf16x8*)(Ks + KSWZ(32 + r32, cb) + kcolB);
        p0 = __builtin_amdgcn_mfma_f32_32x32x16_bf16(b0, qr[d0], p0, 0, 0, 0);
        p1 = __builtin_amdgcn_mfma_f32_32x32x16_bf16(b1, qr[d0], p1, 0, 0, 0); }
}
struct QFix { const float* g; const float* cs; const float* sn; int t0; };
struct Fuse { int role; float lam, post; const float* sg; const bf16* bg; };
constexpr int STASH_OFF = 69632;
static_assert(SHM_ATTN + 512 <= STASH_OFF && STASH_OFF + 8 * 8192 <= MISC_OFF, "attention LDS image / pair stash / MISC overlap");
template <int MODE, int SDEPTH>
__device__ __forceinline__ void attn_unit(const bf16* __restrict__ Qb, const bf16* __restrict__ Kh, const bf16* __restrict__ Vh, bf16* __restrict__ Ob, int ldo, int seq,
                                          float scale, int kcolB, const RetP rp, LAS char* lds, const int tid, const QFix qf, const Fuse fz) {
    constexpr int ND0 = (MODE == 1) ? 4 : 8;
    const int wid = tid >> 6, lane = tid & 63, r32 = lane & 31, hi = lane >> 5;
    LAS char* V_lds = lds; LAS char* K_lds = lds + 2 * SHM_V;
    LAS float* ws = (LAS float*)(lds + 2 * SHM_V + 2 * SHM_K) + wid * 64; LAS float* li_l = ws; LAS float* al_l = ws + 32;
    const float C = scale * LOG2E, thr = 8.f / scale;
    float m_reg = -1e30f, l_reg = 0; f32x16 o[4] = {}; bf16x8 qr[ND0];
    const bf16* Qw = Qb + (long)(wid * 32 + r32) * LDP + hi * 8;
#pragma unroll
    for (int d0 = 0; d0 < ND0; ++d0) qr[d0] = *(const bf16x8*)(Qw + d0 * 16);
    {
        constexpr int NH = ND0 / 2; float xq[ND0][8];
#pragma unroll
        for (int d0 = 0; d0 < ND0; ++d0) unpack8(__builtin_bit_cast(u32x4, qr[d0]), xq[d0]);
        if (MODE == 0) { float ss = 0.f;
#pragma unroll
            for (int d0 = 0; d0 < ND0; ++d0)
#pragma unroll
                for (int e = 0; e < 8; ++e) ss += xq[d0][e] * xq[d0][e];
            ss += shflx(ss, 32, lane);
            const float rstd = rsqrtf(ss * (1.f / 128.f) + EPS);
#pragma unroll
            for (int d0 = 0; d0 < ND0; ++d0) { const f32x4 g0 = *(const f32x4*)(qf.g + d0 * 16 + hi * 8), g1 = *(const f32x4*)(qf.g + d0 * 16 + hi * 8 + 4);
#pragma unroll
                for (int e = 0; e < 4; ++e) { xq[d0][e] *= rstd * g0[e]; xq[d0][4 + e] *= rstd * g1[e]; } } }
        if (qf.t0 >= 0) { const int t = qf.t0 + wid * 32 + r32; const float* cs = qf.cs + (size_t)t * (8 * ND0) + hi * 8; const float* sn = qf.sn + (size_t)t * (8 * ND0) + hi * 8;
#pragma unroll
            for (int d0 = 0; d0 < NH; ++d0) { const f32x4 c0 = *(const f32x4*)(cs + d0 * 16), c1 = *(const f32x4*)(cs + d0 * 16 + 4), s0 = *(const f32x4*)(sn + d0 * 16), s1 = *(const f32x4*)(sn + d0 * 16 + 4);
#pragma unroll
                for (int e = 0; e < 4; ++e) { const float a0 = xq[d0][e], b0 = xq[d0 + NH][e], a1 = xq[d0][4 + e], b1 = xq[d0 + NH][4 + e];
                    xq[d0][e] = a0 * c0[e] - b0 * s0[e]; xq[d0 + NH][e] = b0 * c0[e] + a0 * s0[e]; xq[d0][4 + e] = a1 * c1[e] - b1 * s1[e]; xq[d0 + NH][4 + e] = b1 * c1[e] + a1 * s1[e]; } } }
        if (MODE == 0 || qf.t0 >= 0) {
#pragma unroll
            for (int d0 = 0; d0 < ND0; ++d0) qr[d0] = __builtin_bit_cast(bf16x8, pack8(xq[d0])); }
    }
    const int qs = rp.qs0 + wid * 32 + r32;
    const int qw0 = rp.qs0 + __builtin_amdgcn_readfirstlane(wid) * 32;
    LAS float* rtab = (LAS float*)(lds + 2 * SHM_V + 2 * SHM_K + 2048);
    if (MODE == 2 && tid < 128) rtab[tid] = __builtin_amdgcn_exp2f((tid < 64 ? -rp.lf2 : rp.lb2) * (float)(tid & 63));
    const int sr = tid >> 4, sc = (tid & 15) * 8, vst0 = v_st(sr, sc), vst1 = v_st(32 + sr, sc);
    const int vb0 = (int)(unsigned)(uintptr_t)V_lds + v_rd_base(lane);
    const int tq0 = rp.qs0 >> 6;
    float vf0 = 1.f, vf1 = 1.f, vb0f = 1.f, vb1f = 1.f;
    if (MODE == 2) { vf0 = __builtin_amdgcn_exp2f(rp.lf2 * (float)(63 - sr)); vf1 = __builtin_amdgcn_exp2f(rp.lf2 * (float)(31 - sr)); vb0f = __builtin_amdgcn_exp2f(rp.lb2 * (float)sr); vb1f = __builtin_amdgcn_exp2f(rp.lb2 * (float)(32 + sr)); }
    struct { bf16x8 vs0, vs1, ks0, ks1; } sr_[SDEPTH];
#define SLOAD(i, k0) do { sr_[i].vs0 = *(const bf16x8*)(&Vh[(long)((k0) + sr) * LDP + sc]); sr_[i].vs1 = *(const bf16x8*)(&Vh[(long)((k0) + 32 + sr) * LDP + sc]); \
    sr_[i].ks0 = *(const bf16x8*)(&Kh[(long)((k0) + sr) * LDP + sc]); sr_[i].ks1 = *(const bf16x8*)(&Kh[(long)((k0) + 32 + sr) * LDP + sc]); } while (0)
#define SWRITE(b, i, TILE) do { bf16x8 v0_ = sr_[i].vs0, v1_ = sr_[i].vs1; \
    if (MODE == 2) { const int cls_ = ret_class(TILE, rp.latq, tq0); if (cls_ == 1) { v0_ = scale8(v0_, vf0); v1_ = scale8(v1_, vf1); } else if (cls_ == 2) { v0_ = scale8(v0_, vb0f); v1_ = scale8(v1_, vb1f); } } \
    *(LAS bf16x8*)(V_lds + (b) * SHM_V + vst0) = v0_;          \
    *(LAS bf16x8*)(V_lds + (b) * SHM_V + vst1) = v1_; const int kc = sc * 2;               \
    *(LAS bf16x8*)(K_lds + (b) * SHM_K + KSWZ(sr, kc)) = sr_[i].ks0;                       \
    *(LAS bf16x8*)(K_lds + (b) * SHM_K + KSWZ(32 + sr, kc)) = sr_[i].ks1; } while (0)
#define SWAIT() do { if (SDEPTH == 2) asm volatile("s_waitcnt vmcnt(4)" ::: "memory"); else asm volatile("s_waitcnt vmcnt(0)" ::: "memory"); } while (0)
#define RESC(a) do { if (MODE != 2) { if (__any((a) < 1.f)) { if (hi == 0) al_l[r32] = (a); asm volatile("s_waitcnt lgkmcnt(0)" ::: "memory"); \
    _Pragma("unroll") for (int d = 0; d < 4; ++d) _Pragma("unroll") for (int r = 0; r < 16; ++r) o[d][r] *= al_l[crow(r, hi)]; } } } while (0)
#define PART(P0, P1, MN, AL, TILE) do { if (MODE == 2) { const int cls_ = ret_class(TILE, rp.latq, tq0); \
        if (cls_ == 0) { const float db_ = (float)(qs - (TILE) * 64 - 4 * hi); const int kq_ = (TILE) * 64 - qw0; const float Ff_ = __builtin_amdgcn_exp2f(fmaf(rp.lf2, db_, rp.lrs)); \
            if (rp.latq && (TILE) < 4) retT<3>(P0, P1, Ff_, __builtin_amdgcn_exp2f(fmaf(rp.lb2, (float)TPB - db_, rp.lrs)), db_, rtab); \
            else if (kq_ + 63 < 0) retT<1>(P0, P1, Ff_, 0.f, db_, rtab); \
            else if (kq_ > 31) retT<2>(P0, P1, 0.f, __builtin_amdgcn_exp2f(fmaf(-rp.lb2, db_, rp.lrs)), db_, rtab); \
            else retT<0>(P0, P1, Ff_, __builtin_amdgcn_exp2f(fmaf(-rp.lb2, db_, rp.lrs)), db_, rtab); } \
        else { const float rs_ = __builtin_amdgcn_exp2f(cls_ == 1 ? fmaf(rp.lf2, (float)(qs - (TILE) * 64 - 63), rp.lrs) : fmaf(rp.lb2, (float)((TILE) * 64 - qs), rp.lrs)); \
            _Pragma("unroll") for (int r_ = 0; r_ < 16; ++r_) { P0[r_] *= rs_; P1[r_] *= rs_; } } } \
    else partialSM(P0, P1, m_reg, MN, AL, C, thr); } while (0)
#define FIN(P0, P1, AL) do { if (MODE == 2) packP(P0, P1, pa0, pa1, pa2, pa3); else finishSM(P0, P1, AL, l_reg, pa0, pa1, pa2, pa3); } while (0)
    if (__builtin_amdgcn_readfirstlane(wid) >= 4) __builtin_amdgcn_s_setprio(1);
    f32x16 pA0, pA1, pB0, pB1; float mnA = 0.f, mnB = 0.f, alA = 1.f, alB = 1.f; bf16x8 pa0, pa1, pa2, pa3; const int NT = seq / 64;
    constexpr int SE = 0, SO = SDEPTH - 1;
    SLOAD(SE, 0); asm volatile("s_waitcnt vmcnt(0)" ::: "memory"); SWRITE(0, SE, 0); __syncthreads();
    qkt<ND0>(pA0, pA1, K_lds, qr, r32, hi, kcolB); PART(pA0, pA1, mnA, alA, 0);
    SLOAD(SO, 64); if (SDEPTH == 2) { if (2 < NT) SLOAD(SE, 128); }
    SWAIT(); SWRITE(1, SO, 1); __syncthreads();
    for (int j = 1; j + 1 < NT; j += 2) {
        SBAR(); qkt<ND0>(pB0, pB1, K_lds + SHM_K, qr, r32, hi, kcolB);
        FIN(pA0, pA1, alA); SBAR();
        SLOAD(SO, (j + SDEPTH) * 64); SBAR();
        pv_d0(o, vb0, pa0, pa1, pa2, pa3); PART(pB0, pB1, mnB, alB, j);
        __syncthreads(); SWAIT(); SWRITE(0, SE, j + 1);
        RESC(alB); __syncthreads();
        SBAR(); qkt<ND0>(pA0, pA1, K_lds, qr, r32, hi, kcolB);
        FIN(pB0, pB1, alB); SBAR();
        if (SDEPTH == 1 || j + 3 < NT) SLOAD(SE, (j + 1 + SDEPTH) * 64); SBAR();
        pv_d0(o, vb0 + SHM_V, pa0, pa1, pa2, pa3); PART(pA0, pA1, mnA, alA, j + 1);
        __syncthreads(); SWAIT(); SWRITE(1, SO, j + 2);
        RESC(alA); __syncthreads();
    }
    SBAR(); qkt<ND0>(pB0, pB1, K_lds + SHM_K, qr, r32, hi, kcolB);
    FIN(pA0, pA1, alA); SBAR();
    pv_d0(o, vb0, pa0, pa1, pa2, pa3); PART(pB0, pB1, mnB, alB, NT - 1);
    __syncthreads(); RESC(alB);
    FIN(pB0, pB1, alB); SBAR();
    pv_d0(o, vb0 + SHM_V, pa0, pa1, pa2, pa3);
    __builtin_amdgcn_s_setprio(0);
    float rli[16];
    if (MODE != 2) { if (hi == 0) li_l[r32] = l_reg; asm volatile("s_waitcnt lgkmcnt(0)" ::: "memory");
#pragma unroll
        for (int r = 0; r < 16; ++r) rli[r] = __builtin_amdgcn_rcpf(li_l[crow(r, hi)]); }
    else {
#pragma unroll
        for (int r = 0; r < 16; ++r) rli[r] = 1.f; }
    bf16* Ow = Ob + (long)(wid * 32) * ldo;
    if (MODE == 0 || fz.role == 0) {
#pragma unroll
        for (int r = 0; r < 16; ++r) { const int orow = crow(r, hi);
#pragma unroll
            for (int d0 = 0; d0 < 4; ++d0) Ow[(long)orow * ldo + d0 * 32 + r32] = (bf16)f2bf(o[d0][r] * rli[r]); }
    } else {
        int ln2 = lane; asm volatile("" : "+v"(ln2));
        LAS u32x4* st = (LAS u32x4*)(lds + STASH_OFF + wid * 8192) + ln2;
        if (fz.role == 1) {
#pragma unroll
            for (int i = 0; i < 8; ++i) { const int r0 = 2 * i, r1 = 2 * i + 1; u32x4 w;
                w.x = cvt_pk_bf16(o[0][r0] * rli[r0], o[1][r0] * rli[r0]); w.y = cvt_pk_bf16(o[2][r0] * rli[r0], o[3][r0] * rli[r0]);
                w.z = cvt_pk_bf16(o[0][r1] * rli[r1], o[1][r1] * rli[r1]); w.w = cvt_pk_bf16(o[2][r1] * rli[r1], o[3][r1] * rli[r1]);
                st[i * 64] = w; }
        } else if (MODE == 1) {
            float ssr[16];
#pragma unroll
            for (int i = 0; i < 8; ++i) { const u32x4 w = st[i * 64];
#pragma unroll
                for (int rr = 0; rr < 2; ++rr) { const int r = 2 * i + rr; const unsigned ua = rr ? w.z : w.x, ub = rr ? w.w : w.y; const float sc2 = fz.lam * rli[r];
                    o[0][r] = bflo(ua) - sc2 * o[0][r]; o[1][r] = bfhi(ua) - sc2 * o[1][r]; o[2][r] = bflo(ub) - sc2 * o[2][r]; o[3][r] = bfhi(ub) - sc2 * o[3][r];
                    ssr[r] = o[0][r] * o[0][r] + o[1][r] * o[1][r] + o[2][r] * o[2][r] + o[3][r] * o[3][r]; } }
#pragma unroll
            for (int r = 0; r < 16; ++r) {
#pragma unroll
                for (int x = 1; x < 32; x <<= 1) ssr[r] += shflx(ssr[r], x, lane); }
            const float sg0 = fz.sg[r32], sg1 = fz.sg[32 + r32], sg2 = fz.sg[64 + r32], sg3 = fz.sg[96 + r32];
#pragma unroll
            for (int r = 0; r < 16; ++r) { const int orow = crow(r, hi); const float rstd = rsqrtf(ssr[r] * (1.f / 128.f) + EPS) * fz.post; bf16* op = Ow + (long)orow * ldo + r32;
                op[0] = (bf16)f2bf(o[0][r] * rstd * sg0); op[32] = (bf16)f2bf(o[1][r] * rstd * sg1); op[64] = (bf16)f2bf(o[2][r] * rstd * sg2); op[96] = (bf16)f2bf(o[3][r] * rstd * sg3); }
        } else {
            float mu[16], rs[16];
#pragma unroll
            for (int i = 0; i < 8; ++i) { const u32x4 w = st[i * 64];
#pragma unroll
                for (int rr = 0; rr < 2; ++rr) { const int r = 2 * i + rr; const unsigned ua = rr ? w.z : w.x, ub = rr ? w.w : w.y;
                    mu[r] = (bflo(ua) + bfhi(ua)) + (bflo(ub) + bfhi(ub)) + (o[0][r] + o[1][r]) + (o[2][r] + o[3][r]); } }
#pragma unroll
            for (int r = 0; r < 16; ++r) {
#pragma unroll
                for (int x = 1; x < 32; x <<= 1) mu[r] += shflx(mu[r], x, lane);
                mu[r] *= (1.f / 256.f); }
            asm volatile("" ::: "memory");
#pragma unroll
            for (int i = 0; i < 8; ++i) { const u32x4 w = st[i * 64];
#pragma unroll
                for (int rr = 0; rr < 2; ++rr) { const int r = 2 * i + rr; const unsigned ua = rr ? w.z : w.x, ub = rr ? w.w : w.y; const float m_ = mu[r];
                    const float a0 = bflo(ua) - m_, a1 = bfhi(ua) - m_, a2 = bflo(ub) - m_, a3 = bfhi(ub) - m_, b0 = o[0][r] - m_, b1 = o[1][r] - m_, b2 = o[2][r] - m_, b3 = o[3][r] - m_;
                    rs[r] = (a0 * a0 + a1 * a1) + (a2 * a2 + a3 * a3) + (b0 * b0 + b1 * b1) + (b2 * b2 + b3 * b3); } }
#pragma unroll
            for (int r = 0; r < 16; ++r) {
#pragma unroll
                for (int x = 1; x < 32; x <<= 1) rs[r] += shflx(rs[r], x, lane);
                rs[r] = rsqrtf(rs[r] * (1.f / 256.f) + GN_EPS); }
            const bf16* gw_ = fz.bg + (long)(wid * 32) * LDP + r32;
            asm volatile("" ::: "memory");
#pragma unroll
            for (int i = 0; i < 8; ++i) { const u32x4 w = st[i * 64]; SBAR();
#pragma unroll
                for (int rr = 0; rr < 2; ++rr) { const int r = 2 * i + rr; const unsigned ua = rr ? w.z : w.x, ub = rr ? w.w : w.y; const float m_ = mu[r], q_ = rs[r];
                    const int orow = crow(r, hi); const bf16* gp = gw_ + (long)orow * LDP; bf16* op = Ow + (long)orow * ldo + r32;
                    const float y0[4] = {bflo(ua), bfhi(ua), bflo(ub), bfhi(ub)};
#pragma unroll
                    for (int d0 = 0; d0 < 4; ++d0) { const float g0 = bflo((unsigned)gp[d0 * 32]), g1 = bflo((unsigned)gp[128 + d0 * 32]);
                        op[d0 * 32] = (bf16)f2bf((y0[d0] - m_) * q_ * g0 * sigmoidf_(g0)); op[128 + d0 * 32] = (bf16)f2bf((o[d0][r] - m_) * q_ * g1 * sigmoidf_(g1)); } } }
        }
    }
    __syncthreads();
#undef SLOAD
#undef SWRITE
#undef SWAIT
#undef RESC
#undef PART
#undef FIN
}
}

struct Args {
    const float* x; const float* c; const float* ctx; const float* c_ctx; const float* w_mod; const float* b_mod; const float* norm_g; const float* w_in;
    const float* qk_g; const float* dlam; const float* subln; const float* rdecay; const float* w_branch; const float* w_bgate; const float* w_out;
    const float* ffn_w_in; const float* ffn_w_out; const float* moe_router; const float* moe_w_in; const float* moe_w_out;
    float* out; unsigned char* ws; int ph_lo, ph_hi;
};

__device__ __forceinline__ int map_row(int n, int N, int map) {
    if (map == 1) { const int Nh = N >> 1, h = n / Nh, c = n - h * Nh; return ((c >> 7) << 8) + (h << 7) + (c & 127); }
    if (map == 2) { const int i = n >> 11, c = n & 2047; return i < 2 ? ((c >> 7) << 8) + (i << 7) + (c & 127) : 4096 + c; }
    return n;
}
constexpr float W8SCALE = 64.f;
__device__ __forceinline__ void tr_load(const float* W, int N, int item, int lane, f32x4 (&v)[16]) {
    const int nblk = N >> 6, kb = item / nblk, nb = item - kb * nblk, k0 = kb << 6, n0 = nb << 6;
    const float* src = W + (size_t)(k0 + (lane >> 4)) * N + n0 + ((lane & 15) << 2);
#pragma unroll
    for (int i = 0; i < 16; ++i) v[i] = *(const f32x4*)(src + (size_t)(4 * i) * N);
}
template <int QK> __device__ __forceinline__ void tr_store(const f32x4 (&v)[16], int K, int N, void* WTv, int map, LAS float* scr, int item, int lane, const unsigned* colmax, float* swc) {
    const int nblk = N >> 6, kb = item / nblk, nb = item - kb * nblk, k0 = kb << 6, n0 = nb << 6;
#pragma unroll
    for (int i = 0; i < 16; ++i) { LAS float* d = scr + (4 * i + (lane >> 4)) * 65 + ((lane & 15) << 2); d[0] = v[i][0]; d[1] = v[i][1]; d[2] = v[i][2]; d[3] = v[i][3]; }
    LDS_WAIT(); asm volatile("" ::: "memory");
    const int c = lane & 7, db = map_row(n0, N, map);
#pragma unroll
    for (int j = 0; j < 8; ++j) { const int n = (lane >> 3) + 8 * j; const LAS float* s = scr + (8 * c) * 65 + n;
        if constexpr (QK == 1) { float v8[8];
#pragma unroll
            for (int e = 0; e < 8; ++e) v8[e] = s[e * 65] * W8SCALE;
            *(u32x2*)((unsigned char*)WTv + (size_t)(db + n) * K + k0 + 8 * c) = pack8_fp8(v8); }
        else if constexpr (QK == 2) { float v8[8]; const float cm = __uint_as_float(colmax[n0 + n]), inv = cm > 0.f ? 127.f / cm : 0.f;
#pragma unroll
            for (int e = 0; e < 8; ++e) v8[e] = s[e * 65] * inv;
            *(u32x2*)((unsigned char*)WTv + (size_t)(db + n) * K + k0 + 8 * c) = pack8_i8(v8);
            if (kb == 0 && c == 0) swc[db + n] = cm * (1.f / 127.f); }
        else { u32x4 o; o.x = pk2(s[0 * 65], s[1 * 65]); o.y = pk2(s[2 * 65], s[3 * 65]); o.z = pk2(s[4 * 65], s[5 * 65]); o.w = pk2(s[6 * 65], s[7 * 65]);
            *(u32x4*)((bf16*)WTv + (size_t)(db + n) * K + k0 + 8 * c) = o; } }
    LDS_WAIT(); asm volatile("" ::: "memory");
}
template <int QK> __device__ __forceinline__ void transpose_run(const float* W, int K, int N, void* WTv, int map, LAS float* scr, int it, int ni, int stride, int lane, const unsigned* colmax = nullptr, float* swc = nullptr) {
    if (it >= ni) return;
    f32x4 va[16], vb[16];
    tr_load(W, N, it, lane, va);
    for (;;) {
        const int nx = it + stride; const bool has = nx < ni;
        if (has) tr_load(W, N, nx, lane, vb);
        tr_store<QK>(va, K, N, WTv, map, scr, it, lane, colmax, swc);
        if (!has) break;
#pragma unroll
        for (int i = 0; i < 16; ++i) va[i] = vb[i];
        it = nx;
    }
}
struct MatDesc { const float* W; void* WT; int K, N, map; };
constexpr int NMAT = 30;
__device__ __forceinline__ int mat_items(int id) {
    if (id < 2) return (2048 / 64) * (WIN / 64);
    if (id < 8) return (1024 / 64) * (2048 / 64);
    if (id < 10) return (2048 / 64) * (6144 / 64);
    if (id < 12) return (2048 / 64) * (2048 / 64);
    if (id == 12) return (2048 / 64) * (11264 / 64);
    if (id == 13) return (FF / 64) * (2048 / 64);
    if (id < 22) return (2048 / 64) * (11264 / 64);
    return (FF / 64) * (2048 / 64);
}
template <class AT> __device__ __forceinline__ void mat_desc(AT& a, int id, MatDesc& d) {
    unsigned char* ws = as_global(a.ws);
    if (id < 2) { d.W = as_global(a.w_in) + (size_t)id * 2048 * WIN; d.WT = (bf16*)(ws + WS_WIN) + (size_t)id * WIN * 2048; d.K = 2048; d.N = WIN; d.map = 0; }
    else if (id < 8) { const int j = id - 2; d.W = as_global(a.w_branch) + (size_t)j * 1024 * 2048; d.WT = (bf16*)(ws + WS_WB) + (size_t)j * 2048 * 1024; d.K = 1024; d.N = 2048; d.map = 0; }
    else if (id < 10) { const int j = id - 8; d.W = as_global(a.w_bgate) + (size_t)j * 2048 * 6144; d.WT = (bf16*)(ws + WS_WG) + (size_t)j * 6144 * 2048; d.K = 2048; d.N = 6144; d.map = 2; }
    else if (id < 12) { const int j = id - 10; d.W = as_global(a.w_out) + (size_t)j * 2048 * 2048; d.WT = (bf16*)(ws + WS_WO) + (size_t)j * 2048 * 2048; d.K = 2048; d.N = 2048; d.map = 0; }
    else if (id == 12) { d.W = as_global(a.ffn_w_in); d.WT = ws + WS_WF1; d.K = 2048; d.N = 2 * FF; d.map = 1; }
    else if (id == 13) { d.W = as_global(a.ffn_w_out); d.WT = ws + WS_WF2; d.K = FF; d.N = 2048; d.map = 0; }
    else if (id < 22) { const int j = id - 14; d.W = as_global(a.moe_w_in) + (size_t)j * 2048 * 2 * FF; d.WT = ws + WS_WM1 + (size_t)j * 2 * FF * 2048; d.K = 2048; d.N = 2 * FF; d.map = 1; }
    else { const int j = id - 22; d.W = as_global(a.moe_w_out) + (size_t)j * FF * 2048; d.WT = ws + WS_WM2 + (size_t)j * 2048 * FF; d.K = FF; d.N = 2048; d.map = 0; }
}

constexpr bool q_enabled(int q) { return q == 0 || ((q == 1 || q == 2) && I8_GATES) || (q == 3 && (I8_P1 & 1)) || (q == 4 && (I8_P1 & 2)); }
struct QMat { const float* W; unsigned char* WT; int N, map; };
template <class AT> __device__ __forceinline__ QMat qmat(AT& a, unsigned char* ws, int q) {
    if (q == 0) return QMat{as_global(a.ffn_w_in), ws + WS_WF1, 2 * FF, 1};
    if (q <= 2) return QMat{as_global(a.w_bgate) + (size_t)(q - 1) * 2048 * 6144, ws + WS_WG + (size_t)(q - 1) * 6144 * 2048, 6144, 2};
    return QMat{as_global(a.w_in) + (size_t)(q - 3) * 2048 * WIN, ws + WS_WIN + (size_t)(q - 3) * WIN * 2048, WIN, 0};
}
constexpr int NWAVES = 8;
typedef __attribute__((address_space(4))) const Args CArgs;
__device__ __forceinline__ CArgs* phase_args() { CArgs* p = (CArgs*)__builtin_amdgcn_kernarg_segment_ptr(); asm volatile("" : "+s"(p)); return p; }
__device__ __forceinline__ int lat_row(int it) { return it + ((it >> 11) + 1) * CTXL; }

__device__ __forceinline__ void row_update(const void* xin, bool xin_f32, void* xout, bool xout_f32, float (&yv)[32], float rstd_y, const float* mg, const float* gg,
                                           bool do_norm, const float* ng, const float* nsc, const float* nsh, bf16* hout, unsigned char* hout8, float* sarow, int lane) {
    float xv[32]; float sx = 0.f;
#pragma unroll
    for (int j = 0; j < 4; ++j) { const int c0 = 512 * j + 8 * lane;
        f32x4 v0, v1;
        if (xin_f32) { v0 = *(const f32x4*)((const float*)xin + c0); v1 = *(const f32x4*)((const float*)xin + c0 + 4); }
        else { float t[8]; unpack8(*(const u32x4*)((const bf16*)xin + c0), t); v0 = (f32x4){t[0], t[1], t[2], t[3]}; v1 = (f32x4){t[4], t[5], t[6], t[7]}; }
        const f32x4 m0 = *(const f32x4*)(mg + c0), m1 = *(const f32x4*)(mg + c0 + 4), g0 = *(const f32x4*)(gg + c0), g1 = *(const f32x4*)(gg + c0 + 4);
#pragma unroll
        for (int e = 0; e < 4; ++e) { v0[e] += m0[e] * g0[e] * yv[8 * j + e] * rstd_y; v1[e] += m1[e] * g1[e] * yv[8 * j + 4 + e] * rstd_y; xv[8 * j + e] = v0[e]; xv[8 * j + 4 + e] = v1[e]; sx += v0[e] * v0[e] + v1[e] * v1[e]; }
        if (xout_f32) { *(f32x4*)((float*)xout + c0) = v0; *(f32x4*)((float*)xout + c0 + 4) = v1; }
        else { const float t[8] = {v0[0], v0[1], v0[2], v0[3], v1[0], v1[1], v1[2], v1[3]}; *(u32x4*)((bf16*)xout + c0) = pack8(t); } }
    if (do_norm) {
        const float rstd_x = rsqrtf(wave_sum(sx, lane) * (1.f / D) + EPS);
#pragma unroll
        for (int j = 0; j < 4; ++j) { const int c0 = 512 * j + 8 * lane; float o[8];
            const f32x4 n0 = *(const f32x4*)(ng + c0), n1 = *(const f32x4*)(ng + c0 + 4), s0 = *(const f32x4*)(nsc + c0), s1 = *(const f32x4*)(nsc + c0 + 4), h0 = *(const f32x4*)(nsh + c0), h1 = *(const f32x4*)(nsh + c0 + 4);
#pragma unroll
            for (int e = 0; e < 4; ++e) { o[e] = xv[8 * j + e] * rstd_x * n0[e] * (1.f + s0[e]) + h0[e]; o[4 + e] = xv[8 * j + 4 + e] * rstd_x * n1[e] * (1.f + s1[e]) + h1[e]; }
#pragma unroll
            for (int e = 0; e < 8; ++e) yv[8 * j + e] = o[e];
            if (hout) *(u32x4*)(hout + c0) = pack8(o);
            if (hout8 && !sarow) *(u32x2*)(hout8 + c0) = pack8_fp8(o); }
        if (hout8 && sarow) {
            float am = 0.f;
#pragma unroll
            for (int e = 0; e < 32; ++e) am = fmaxf(am, fabsf(yv[e]));
#pragma unroll
            for (int o_ = 1; o_ < 64; o_ <<= 1) am = fmaxf(am, shflx(am, o_, lane));
            const float inv = am > 0.f ? 127.f / am : 0.f;
#pragma unroll
            for (int j = 0; j < 4; ++j) { float q[8];
#pragma unroll
                for (int e = 0; e < 8; ++e) q[e] = yv[8 * j + e] * inv;
                *(u32x2*)(hout8 + 512 * j + 8 * lane) = pack8_i8(q); }
            if (lane == 0) *sarow = am * (1.f / 127.f);
        }
    }
}

__global__ void __launch_bounds__(NWAVES * 64, 2) fwd_kernel(Args a_unused) {
    extern __shared__ __attribute__((aligned(16))) unsigned char lds_raw[];
    LAS unsigned char* lds = (LAS unsigned char*)lds_raw;
    volatile LAS unsigned* MISC = (volatile LAS unsigned*)(lds + MISC_OFF);
    const int tid = threadIdx.x, lane = tid & 63, wave = __builtin_amdgcn_readfirstlane(tid >> 6);
    const int G = gridDim.x, bx = blockIdx.x;
    const int vcu = (G % 8 == 0) ? (bx % 8) * (G / 8) + bx / 8 : bx;
    const int gw = vcu * NWAVES + wave, NGW = G * NWAVES;
    for (int u = tid; u < (LDS_BYTES - MISC_OFF) / 4; u += NWAVES * 64) ((LAS unsigned*)(lds + MISC_OFF))[u] = 0u;
    __syncthreads();
    int ph_lo, ph_hi; XcdBarrier bar;
    { CArgs* ap = phase_args(); ph_lo = ap->ph_lo; ph_hi = ap->ph_hi; unsigned* ctl = (unsigned*)(as_global(ap->ws) + WS_CTL);
      bar.bar = ctl + CW_BAR; bar.x = 0; bar.st = nullptr;
      if (ph_hi - ph_lo > 1) bar = xcd_barrier_post(ctl + CW_BAR, MISC + 8); }
    int phase = 0;
#define PH_BEGIN asm volatile("" : "+s"(phase)); if (ph_lo <= phase && phase < ph_hi) { CArgs& a = *phase_args(); unsigned char* const ws = as_global(a.ws); (void)ws; int tid_l; asm volatile("v_mbcnt_lo_u32_b32 %0, -1, 0\n\tv_mbcnt_hi_u32_b32 %0, -1, %0" : "=v"(tid_l)); tid_l += wave * 64; const int tid = tid_l, lane = tid & 63; (void)lane;
#define PH_END_NB } ++phase;
#define PH_END_IF(c) asm volatile("" : "+s"(phase)); if ((c) && phase + 1 < ph_hi) { XcdBarrier b2 = bar; asm volatile("" : "+s"(b2.bar), "+s"(b2.x)); b2.bar = as_global(b2.bar); xcd_barrier(b2); } } ++phase;
#define PH_END   asm volatile("" : "+s"(phase)); if (phase + 1 < ph_hi) { XcdBarrier b2 = bar; asm volatile("" : "+s"(b2.bar), "+s"(b2.x)); b2.bar = as_global(b2.bar); xcd_barrier(b2); } } ++phase;
#define MVEC ((float*)(ws + WS_MVEC))
#define COS64 ((float*)(ws + WS_ROPE))
#define SIN64 (COS64 + 2048 * 32)
#define COS128 (COS64 + 2 * 2048 * 32)
#define SIN128 (COS128 + 2048 * 64)
#define Hb ((bf16*)(ws + WS_H))
#define HQ ((unsigned char*)(ws + WS_HQ))
#define SAH ((float*)(ws + WS_SAH))
#define SWALL ((float*)(ws + WS_SWALL))
#define COLMAX ((unsigned*)(ws + WS_CTL + CTL_COLMAX))
#define H8 ((unsigned char*)(ws + WS_H))
#define HG8 ((unsigned char*)(ws + WS_HG))
#define ACT8 ((unsigned char*)(ws + S_ACT))
#define XRES ((bf16*)(ws + WS_XRES))
#define P ((bf16*)(ws + S_P))
#define OA ((bf16*)(ws + S_OA))
#define OB ((bf16*)(ws + S_OB))
#define OCAT ((bf16*)(ws + S_OCAT))
#define BB ((bf16*)(ws + S_BB))
#define Y2 ((bf16*)(ws + S_Y2))
#define Yb ((bf16*)(ws + S_Y))
#define YO ((bf16*)(ws + S_YO))
#define ACT ((bf16*)(ws + S_ACT))
#define FO ((bf16*)(ws + S_FO))
#define TOK_E ((int*)(ws + T_E))
#define TOK_W ((float*)(ws + T_W))
#define TOK_LP ((int*)(ws + T_LP))
#define TOK_SLOT ((int*)(ws + T_SLOT))
#define SLOT_W ((float*)(ws + T_SW))
#define CNTWG ((int*)(ws + T_CNT))
#define TSG ((int*)(ws + T_TS))

    PH_BEGIN
    {
        LAS float* cond = (LAS float*)lds;
        LAS float* red = (LAS float*)(lds + 17 * 1024 * 4);
        for (int unit = vcu; unit < 2 * 192; unit += G) {
            const int l = unit / 192, n0 = (unit % 192) * 64;
            float accv[17];
#pragma unroll
            for (int r = 0; r < 17; ++r) accv[r] = 0.f;
            for (int kh = 0; kh < 2; ++kh) {
                __syncthreads();
                for (int i = tid; i < 17 * 1024; i += NWAVES * 64) { const int r = i >> 10, k = (i & 1023) + kh * 1024; const float v = r < 16 ? as_global(a.c)[r * D + k] : as_global(a.c_ctx)[k]; cond[i] = v * sigmoidf_(v); }
                __syncthreads();
                const float* wp = as_global(a.w_mod) + ((size_t)l * D + kh * 1024 + wave * 128) * (6 * D) + n0 + lane;
#pragma unroll 8
                for (int k = 0; k < 128; ++k) { const float w = wp[(size_t)k * (6 * D)];
#pragma unroll
                    for (int r = 0; r < 17; ++r) accv[r] = fmaf(cond[r * 1024 + wave * 128 + k], w, accv[r]); }
            }
#pragma unroll
            for (int r = 0; r < 17; ++r) red[(wave * 17 + r) * 64 + lane] = accv[r];
            __syncthreads();
            for (int i = tid; i < 17 * 64; i += NWAVES * 64) { const int r = i >> 6, n = i & 63; float s = 0.f;
#pragma unroll
                for (int w = 0; w < 8; ++w) s += red[(w * 17 + r) * 64 + n];
                MVEC[((size_t)l * 17 + r) * (6 * D) + n0 + n] = s + as_global(a.b_mod)[(size_t)l * 6 * D + n0 + n]; }
        }
        __syncthreads();
        for (int i = bx * (NWAVES * 64) + tid; i < 2048 * 96; i += G * NWAVES * 64) {
            const int t = i / 96, j = i % 96; const float row = (float)(t >> 6), col = (float)(t & 63);
            if (j < 32) { const int q = j & 15; const float inv = __builtin_amdgcn_exp2f(-(float)q * (13.287712379549449f / 16.f)); const float ang = (j < 16 ? row : col) * inv; float sn, cs; sincosf(ang, &sn, &cs); COS64[t * 32 + j] = cs; SIN64[t * 32 + j] = sn; }
            else { const int jj = j - 32, q = jj & 31; const float inv = __builtin_amdgcn_exp2f(-(float)q * (13.287712379549449f / 32.f)); const float ang = (jj < 32 ? row : col) * inv; float sn, cs; sincosf(ang, &sn, &cs); COS128[t * 64 + jj] = cs; SIN128[t * 64 + jj] = sn; }
        }
#pragma unroll
        for (int q = 0; q < 5; ++q) if (q_enabled(q)) { const QMat qm = qmat(a, ws, q); unsigned* colmax = COLMAX + QOFF[q]; const int nblk = qm.N / 64;
          const bool up_ = (G == 256) && vcu >= 128; const int nsl_ = (G == 256) ? 3 * (NGW / 2) : NGW, s0_ = (G == 256) ? (up_ ? NGW / 2 + 2 * (gw - NGW / 2) : gw) : gw;
          for (int sl_ = 0; sl_ < (up_ ? 2 : 1); ++sl_)
          for (int it = s0_ + sl_; it < nblk * 8; it += nsl_) { const int nb = it % nblk, ks = it / nblk, n0 = nb * 64, k0 = ks * 256;
              const float* src = qm.W + (size_t)(k0 + (lane >> 4)) * qm.N + n0 + ((lane & 15) << 2);
              f32x4 mx = {0.f, 0.f, 0.f, 0.f};
#pragma unroll 8
              for (int i = 0; i < 64; ++i) { const f32x4 v = *(const f32x4*)(src + (size_t)(4 * i) * qm.N);
#pragma unroll
                  for (int e = 0; e < 4; ++e) mx[e] = fmaxf(mx[e], fabsf(v[e])); }
#pragma unroll
              for (int e = 0; e < 4; ++e) { mx[e] = fmaxf(mx[e], shflx(mx[e], 16, lane)); mx[e] = fmaxf(mx[e], shflx(mx[e], 32, lane)); }
              if (lane < 16) {
#pragma unroll
                  for (int e = 0; e < 4; ++e) atomicMax(colmax + n0 + 4 * lane + e, __float_as_uint(mx[e])); } } }
    }
    PH_END

#define MOE_CONV() do { __syncthreads(); int ln_; asm volatile("v_mbcnt_lo_u32_b32 %0, -1, 0\n\tv_mbcnt_hi_u32_b32 %0, -1, %0" : "=v"(ln_));     \
        LAS float* scr_ = (LAS float*)(lds + wave * 16640); int base_ = 0;                                             \
        for (int id = 2; id < NMAT; ++id) { if (id == 12 || (id == 8 || id == 9)) continue;                                                                 \
            const int ni = mat_items(id); int it = gw - (base_ % NGW); if (it < 0) it += NGW;                                                               \
            if (it < ni) { MatDesc d; mat_desc(a, id, d);                                                                                                   \
                if (id < 14) transpose_run<0>(d.W, d.K, d.N, d.WT, d.map, scr_, it, ni, NGW, ln_);                                                         \
                else transpose_run<1>(d.W, d.K, d.N, d.WT, d.map, scr_, it, ni, NGW, ln_); } base_ += ni; }                                                \
        _Pragma("unroll") for (int q = 0; q < 5; ++q) if (q != 3) { const QMat qm = qmat(a, ws, q);                                                          \
            transpose_run<2>(qm.W, 2048, qm.N, qm.WT, qm.map, scr_, gw, (2048 / 64) * (qm.N / 64), NGW, ln_, COLMAX + QOFF[q], SWALL + QOFF[q]); }          \
        __syncthreads(); } while (0)
    const int cgrp = (G % 8 == 0) ? (vcu / (G / 8)) & 3 : (vcu & 3);
    static_assert(I8_GATES == 1 && I8_P1 == 3, "the attention-phase conversion chunk assumes matrices 0, 1, 8, 9, 12 are the int8 ones (quantised in the R1 phase)");
#pragma unroll 1
    for (int l = 0; l < 2; ++l) {
        const bool last_layer = (l == 1);
        const float lam_init = l == 0 ? 0.2f : 0.35550906759096924f;
        const int nMv = l == 0 ? M / 256 : NTOK / 256, skipctx = l == 0 ? 0 : 1;

        PH_BEGIN
        if (l == 0) {
            const float* ng = as_global(a.norm_g); const float* mv = MVEC;
            for (int row = gw; row < M; row += NGW) {
                const int b = row / TPB, pos = row - b * TPB; const int r = pos < CTXL ? 16 : b;
                const float* src = pos < CTXL ? as_global(a.ctx) + ((size_t)b * CTXL + pos) * D : as_global(a.x) + ((size_t)b * SEQ + (pos - CTXL)) * D;
                float xv[32]; float ss = 0.f;
#pragma unroll
                for (int j = 0; j < 4; ++j) { const f32x4 v0 = *(const f32x4*)(src + 512 * j + 8 * lane), v1 = *(const f32x4*)(src + 512 * j + 8 * lane + 4);
#pragma unroll
                    for (int e = 0; e < 4; ++e) { xv[8 * j + e] = v0[e]; xv[8 * j + 4 + e] = v1[e]; ss += v0[e] * v0[e] + v1[e] * v1[e]; }
                }
                const float rstd = rsqrtf(wave_sum(ss, lane) * (1.f / D) + EPS);
                const float* msh = mv + (size_t)r * 6 * D, *msc = msh + D;
                float am = 0.f;
#pragma unroll
                for (int j = 0; j < 4; ++j) { float o[8]; const int c0 = 512 * j + 8 * lane;
#pragma unroll
                    for (int e = 0; e < 8; ++e) { o[e] = xv[8 * j + e] * rstd * ng[c0 + e] * (1.f + msc[c0 + e]) + msh[c0 + e]; xv[8 * j + e] = o[e]; am = fmaxf(am, fabsf(o[e])); }
                    if (!(I8_GATES && (I8_P1 & 1))) *(u32x4*)(Hb + (size_t)row * D + c0) = pack8(o); }
                if (I8_GATES || (I8_P1 & 1)) {
#pragma unroll
                    for (int o_ = 1; o_ < 64; o_ <<= 1) am = fmaxf(am, shflx(am, o_, lane));
                    const float inv = am > 0.f ? 127.f / am : 0.f;
#pragma unroll
                    for (int j = 0; j < 4; ++j) { float q8[8];
#pragma unroll
                        for (int e = 0; e < 8; ++e) q8[e] = xv[8 * j + e] * inv;
                        *(u32x2*)(HQ + (size_t)row * D + 512 * j + 8 * lane) = pack8_i8(q8); }
                    if (lane == 0) SAH[row] = am * (1.f / 127.f);
                }
            }
            {
                LAS float* scr = (LAS float*)(lds + wave * 16640);
#pragma unroll
                for (int q = 3; q < 4; ++q) if (q_enabled(q)) { const QMat qm = qmat(a, ws, q);
                    transpose_run<2>(qm.W, 2048, qm.N, qm.WT, qm.map, scr, gw, (2048 / 64) * (qm.N / 64), NGW, lane, COLMAX + QOFF[q], SWALL + QOFF[q]); }
            }
        }
        PH_END_IF(l == 0)

        PH_BEGIN
        {
            pg8::Sched S{(const char*)Hb, (const char*)(ws + WS_WIN) + (size_t)l * WIN * 2048 * 2, 4096, 4096, l == 0 ? M / 256 : NTOK / 256, WIN / 256, G, bx, l == 0 ? 0 : 1, 1 << 20, 0, nullptr, 0, l == 0 ? 0 : 256};
            if ((I8_P1 >> l) & 1) {
                S.A = (const char*)HQ; S.B = (const char*)(ws + WS_WIN) + (size_t)l * WIN * 2048; S.ldaB = 2048; S.kB = 2048;
                pg8::EpiStore<true> E{P, WIN, nullptr, 1.f, SAH, SWALL + QOFF[3 + l]};
                pg8::gemm_phase<pg8::EpiStore<true>, 2>(lds, S, E, tid);
            } else {
                pg8::EpiStore<false> E{P, WIN, nullptr, 1.f, nullptr, nullptr};
                pg8::gemm_phase<pg8::EpiStore<false>, 0>(lds, S, E, tid);
            }
        }
        PH_END

        PH_BEGIN
        {
            const float* qg = as_global(a.qk_g) + (size_t)l * 2 * 128 + 128;
            for (int row = gw; row < M; row += NGW) {
                const int b = row / TPB, pos = row - b * TPB; const bool lat = pos >= CTXL; const int t = pos - CTXL;
                bf16* pr = P + (size_t)row * WIN;
                if (lat) { const int v = lane >> 2, c = lane & 3; bf16* p1 = pr + O_AK + v * 64 + 8 * c; bf16* p2 = p1 + 32;
                    float x1[8], x2[8], o1[8], o2[8]; unpack8(*(const u32x4*)p1, x1); unpack8(*(const u32x4*)p2, x2);
                    const float* cs = COS64 + t * 32 + 8 * c; const float* sn = SIN64 + t * 32 + 8 * c;
#pragma unroll
                    for (int e = 0; e < 8; ++e) { o1[e] = x1[e] * cs[e] - x2[e] * sn[e]; o2[e] = x2[e] * cs[e] + x1[e] * sn[e]; }
                    *(u32x4*)p1 = pack8(o1); *(u32x4*)p2 = pack8(o2); }
                {
                    const bool isB = lane < 32, isC = lane >= 32 && lane < 48; const int v = isB ? (lane >> 3) : ((lane >> 3) & 1), c = lane & 7;
                    bf16* p1 = pr + (isB ? O_BK : O_CK) + v * 128 + 8 * c; bf16* p2 = p1 + 64;
                    float x1[8], x2[8], o1[8], o2[8]; unpack8(*(const u32x4*)p1, x1); unpack8(*(const u32x4*)p2, x2);
                    float ss = 0.f;
#pragma unroll
                    for (int e = 0; e < 8; ++e) ss += x1[e] * x1[e] + x2[e] * x2[e];
                    ss += shflx(ss, 1, lane); ss += shflx(ss, 2, lane); ss += shflx(ss, 4, lane);
                    const float rstd = isC ? rsqrtf(ss * (1.f / 128.f) + EPS) : 1.f;
#pragma unroll
                    for (int e = 0; e < 8; ++e) { x1[e] *= rstd * (isC ? qg[8 * c + e] : 1.f); x2[e] *= rstd * (isC ? qg[64 + 8 * c + e] : 1.f); }
                    if (lat) { const float* cs = COS128 + t * 64 + 8 * c; const float* sn = SIN128 + t * 64 + 8 * c;
#pragma unroll
                        for (int e = 0; e < 8; ++e) { o1[e] = x1[e] * cs[e] - x2[e] * sn[e]; o2[e] = x2[e] * cs[e] + x1[e] * sn[e]; } }
                    else {
#pragma unroll
                        for (int e = 0; e < 8; ++e) { o1[e] = x1[e]; o2[e] = x2[e]; } }
                    if (isC || (isB && lat)) { *(u32x4*)p1 = pack8(o1); *(u32x4*)p2 = pack8(o2); }
                }
            }
        }
        PH_END

        PH_BEGIN
        {
            const att::RetP rp0{0.f, 0.f, 0.f, 0, 0};
            const float* dl = as_global(a.dlam) + (size_t)l * 4 * 64;
            const float lam = __expf(wave_sum(dl[lane] * dl[64 + lane], lane)) - __expf(wave_sum(dl[128 + lane] * dl[192 + lane], lane)) + lam_init;
            const float* sg = as_global(a.subln) + (size_t)l * 128;
            const int npair = 1024 + (l == 0 ? 128 : 0);
            if (l == 0 && cgrp == 0) MOE_CONV();
            for (int i = 0; ; ++i) {
                const int pu = vcu + (i >> 1) * G; if (pu >= npair) break;
                const int s = i & 1;
                int tid_u; asm volatile("v_mbcnt_lo_u32_b32 %0, -1, 0\n\tv_mbcnt_hi_u32_b32 %0, -1, %0" : "=v"(tid_u)); tid_u += wave * 64;
                int b, h, q0, seq, t0;
                if (pu < 1024) { const int qb = pu & 7; h = (pu >> 3) & 7; b = pu >> 6; q0 = b * TPB + CTXL + qb * 256; seq = TPB; t0 = qb * 256; }
                else { const int v = pu - 1024; h = v & 7; b = v >> 3; q0 = b * TPB; seq = CTXL; t0 = -1; }
                const int k0 = b * TPB;
                att::attn_unit<1, 2>(P + (size_t)q0 * WIN + O_AQ + h * 128 + s * 64, P + (size_t)k0 * WIN + O_AK + h * 128, P + (size_t)k0 * WIN + O_AV + h * 128,
                                  OCAT + (size_t)q0 * 3072 + h * 128, 3072, seq, 0.125f, s * 128, rp0, (LAS char*)lds, tid_u, att::QFix{nullptr, COS64, SIN64, t0},
                                  att::Fuse{1 + s, lam, 1.f - lam_init, sg, nullptr});
            }
            if (l == 0 && cgrp == 1) MOE_CONV();
        }
        PH_END_NB
        PH_BEGIN
        {
            const att::RetP rp0{0.f, 0.f, 0.f, 0, 0};
            const int nctx = l == 0 ? 128 : 0;
            const int vc2 = (G % 64 == 0) ? (vcu + G / 2) % G : vcu;
            for (int u = vc2; u < 1024 + nctx; u += G) {
                int tid_u; asm volatile("v_mbcnt_lo_u32_b32 %0, -1, 0\n\tv_mbcnt_hi_u32_b32 %0, -1, %0" : "=v"(tid_u)); tid_u += wave * 64;
                int b, hq, q0, seq, t0;
                if (u < 1024) { const int qb = u & 7; hq = (u >> 3) & 7; b = u >> 6; q0 = b * TPB + CTXL + qb * 256; seq = TPB; t0 = qb * 256; }
                else { const int v = u - 1024; hq = v & 7; b = v >> 3; q0 = b * TPB; seq = CTXL; t0 = -1; }
                const int k0 = b * TPB, kvh = hq >> 2;
                att::attn_unit<0, 2>(P + (size_t)q0 * WIN + O_CQ + hq * 128, P + (size_t)k0 * WIN + O_CK + kvh * 128, P + (size_t)k0 * WIN + O_CV + kvh * 128,
                                  OCAT + (size_t)q0 * 3072 + 2048 + hq * 128, 3072, seq, 0.08838834764831845f, 0, rp0, (LAS char*)lds, tid_u, att::QFix{as_global(a.qk_g) + (size_t)l * 256, COS128, SIN128, t0},
                                  att::Fuse{0, 0.f, 0.f, nullptr, nullptr});
            }
            if (l == 0 && cgrp == 2) MOE_CONV();
        }
        PH_END_NB
        PH_BEGIN
        {
            const int npair = 512 + (l == 0 ? 64 : 0);
            const int vc3 = (G % 64 == 0) ? (vcu + G / 4) % G : vcu;
            for (int i = 0; ; ++i) {
                const int pu = vc3 + (i >> 1) * G; if (pu >= npair) break;
                const int vh = i & 1;
                int tid_u; asm volatile("v_mbcnt_lo_u32_b32 %0, -1, 0\n\tv_mbcnt_hi_u32_b32 %0, -1, %0" : "=v"(tid_u)); tid_u += wave * 64;
                int b, h, q0, seq, qs0, latq, t0;
                if (pu < 512) { const int qb = pu & 7; h = (pu >> 3) & 3; b = pu >> 5; q0 = b * TPB + CTXL + qb * 256; seq = TPB; qs0 = CTXL + qb * 256; latq = 1; t0 = qb * 256; }
                else { const int v = pu - 512; h = v & 3; b = v >> 2; q0 = b * TPB; seq = CTXL; qs0 = 0; latq = 0; t0 = -1; }
                const int k0 = b * TPB;
                const att::RetP rp{as_global(a.rdecay)[(l * 2 + 0) * 4 + h] * LOG2E, as_global(a.rdecay)[(l * 2 + 1) * 4 + h] * LOG2E, -3.5f, qs0, latq};
                att::attn_unit<2, 2>(P + (size_t)q0 * WIN + O_BQ + h * 128, P + (size_t)k0 * WIN + O_BK + h * 128, P + (size_t)k0 * WIN + O_BV + h * 256 + vh * 128,
                                  OCAT + (size_t)q0 * 3072 + 1024 + h * 256, 3072, seq, 1.f, 0, rp, (LAS char*)lds, tid_u, att::QFix{nullptr, COS128, SIN128, t0},
                                  att::Fuse{1 + vh, 0.f, 0.f, nullptr, P + (size_t)q0 * WIN + O_BG + h * 256});
            }
            if (l == 0 && cgrp == 3) MOE_CONV();
        }
        PH_END

        PH_BEGIN
        PH_END_NB

        PH_BEGIN
        {
            pg8::Sched S{(const char*)OCAT, (const char*)(ws + WS_WB) + (size_t)l * 3 * 2048 * 1024 * 2, 6144, 2048, nMv, 24, G, bx, skipctx, 8, 2048, nullptr, 0, 0};
            pg8::EpiStore<false> E{BB, 6144, nullptr, 1.f, nullptr, nullptr};
            pg8::gemm_phase<pg8::EpiStore<false>, 0>(lds, S, E, tid);
        }
        PH_END
        PH_BEGIN
        {
            pg8::Sched S{(const char*)Hb, (const char*)(ws + WS_WG) + ((size_t)l * 6144 + 4096) * 2048 * 2, 4096, 4096, nMv, 8, G, bx, skipctx, 1 << 20, 0, nullptr, 0, 0};
            if (I8_GATES) {
                S.A = (const char*)HQ; S.B = (const char*)(ws + WS_WG) + ((size_t)l * 6144 + 4096) * 2048; S.ldaB = 2048; S.kB = 2048;
                pg8::EpiG2<true> E{Y2, BB, SAH, SWALL + QOFF[1 + l] + 4096};
                pg8::gemm_phase<pg8::EpiG2<true>, 2>(lds, S, E, tid);
            } else {
                pg8::EpiG2<false> E{Y2, BB, nullptr, nullptr};
                pg8::gemm_phase<pg8::EpiG2<false>, 0>(lds, S, E, tid);
            }
        }
        PH_END
        PH_BEGIN
        {
            pg8::Sched S{(const char*)Hb, (const char*)(ws + WS_WG) + (size_t)l * 6144 * 2048 * 2, 4096, 4096, nMv, 16, G, bx, skipctx, 1 << 20, 0, nullptr, 0, 0};
            if (I8_GATES) {
                S.A = (const char*)HQ; S.B = (const char*)(ws + WS_WG) + (size_t)l * 6144 * 2048; S.ldaB = 2048; S.kB = 2048;
                pg8::EpiG01<true> E{Yb, Y2, BB, (DBG_BRANCH_MASK >> 0) & 1, (DBG_BRANCH_MASK >> 1) & 1, (DBG_BRANCH_MASK >> 2) & 1, SAH, SWALL + QOFF[1 + l]};
                pg8::gemm_phase<pg8::EpiG01<true>, 2>(lds, S, E, tid);
            } else {
                pg8::EpiG01<false> E{Yb, Y2, BB, (DBG_BRANCH_MASK >> 0) & 1, (DBG_BRANCH_MASK >> 1) & 1, (DBG_BRANCH_MASK >> 2) & 1, nullptr, nullptr};
                pg8::gemm_phase<pg8::EpiG01<false>, 0>(lds, S, E, tid);
            }
        }
        PH_END
        PH_BEGIN
        {
            pg8::Sched S{(const char*)Yb, (const char*)(ws + WS_WO) + (size_t)l * 2048 * 2048 * 2, 4096, 4096, nMv, 8, G, bx, skipctx, 1 << 20, 0, nullptr, 0, 0};
            pg8::EpiStore<false> E{YO, 2048, nullptr, 1.f, nullptr, nullptr};
            pg8::gemm_phase<pg8::EpiStore<false>, 0>(lds, S, E, tid);
        }
        PH_END

        PH_BEGIN
        {
            LAS float* rt = (LAS float*)lds;
            LAS int* lcnt = (LAS int*)(lds + MISC_OFF + 256);
            if (l == 1) {
                for (int i = tid; i < 8 * 2048; i += NWAVES * 64) { const int e = i >> 11, k = i & 2047; rt[i] = as_global(a.moe_router)[(size_t)k * 8 + e]; }
                if (tid < 8) lcnt[tid] = 0;
                __syncthreads();
            }
            const float* ng = as_global(a.norm_g) + (size_t)l * 4 * D; const float* mv = MVEC + (size_t)l * 17 * 6 * D;
            const int per = l == 0 ? M / 2048 : NTOK / 2048;
            const int nrows = l == 0 ? M : NTOK;
            for (int it0 = gw * per; it0 < nrows; it0 += NGW * per)
            for (int it = it0; it < it0 + per; ++it) {
                const int row = l == 0 ? it : lat_row(it);
                const int b = row / TPB, pos = row - b * TPB; const int r = pos < CTXL ? 16 : b;
                const float* mr = mv + (size_t)r * 6 * D;
                float yv[32]; float ss = 0.f;
#pragma unroll
                for (int j = 0; j < 4; ++j) { float t8[8]; unpack8(*(const u32x4*)(YO + (size_t)row * D + 512 * j + 8 * lane), t8);
#pragma unroll
                    for (int e = 0; e < 8; ++e) { yv[8 * j + e] = t8[e]; ss += t8[e] * t8[e]; } }
                const float rstd_y = rsqrtf(wave_sum(ss, lane) * (1.f / D) + EPS);
                bf16* xp = XRES + (size_t)row * D;
                const void* xsrc = l == 1 ? (const void*)xp : (const void*)(pos < CTXL ? as_global(a.ctx) + ((size_t)b * CTXL + pos) * D : as_global(a.x) + ((size_t)b * SEQ + (pos - CTXL)) * D);
                row_update(xsrc, l == 0, xp, false, yv, rstd_y, mr + 2 * D, ng + D, true, ng + 2 * D, mr + 4 * D, mr + 3 * D, nullptr, H8 + (size_t)row * D, l == 0 ? (float*)(ws + T_SA) + row : nullptr, lane);
                if (l == 1) {
                    float lg[8];
#pragma unroll
                    for (int e = 0; e < 8; ++e) { float s = 0.f;
#pragma unroll
                        for (int j = 0; j < 4; ++j) { const f32x4 r0 = *(const LAS f32x4*)(rt + e * 2048 + 512 * j + 8 * lane), r1 = *(const LAS f32x4*)(rt + e * 2048 + 512 * j + 8 * lane + 4);
#pragma unroll
                            for (int q = 0; q < 4; ++q) s += yv[8 * j + q] * r0[q] + yv[8 * j + 4 + q] * r1[q]; }
                        lg[e] = wave_sum(s, lane); }
                    int e1 = 0; float v1 = lg[0];
#pragma unroll
                    for (int e = 1; e < 8; ++e) if (lg[e] > v1) { v1 = lg[e]; e1 = e; }
                    int e2 = 0; float v2 = -3.4e38f;
#pragma unroll
                    for (int e = 0; e < 8; ++e) if (e != e1 && lg[e] > v2) { v2 = lg[e]; e2 = e; }
                    const float w1 = 1.f / (1.f + __expf(v2 - v1)), w2 = 1.f - w1;
                    if (lane == 0) { const int p1 = __hip_atomic_fetch_add(&lcnt[e1], 1, __ATOMIC_RELAXED, __HIP_MEMORY_SCOPE_WORKGROUP), p2 = __hip_atomic_fetch_add(&lcnt[e2], 1, __ATOMIC_RELAXED, __HIP_MEMORY_SCOPE_WORKGROUP);
                        TOK_E[2 * it] = e1; TOK_E[2 * it + 1] = e2; TOK_W[2 * it] = w1; TOK_W[2 * it + 1] = w2; TOK_LP[2 * it] = p1; TOK_LP[2 * it + 1] = p2; }
                }
            }
            if (l == 1) { __syncthreads(); if (tid < 8) CNTWG[vcu * 8 + tid] = lcnt[tid]; }
            else if (bx == 0 && tid < 9) TSG[tid] = tid == 0 ? 0 : M / 256;
        }
        PH_END

        PH_BEGIN
        if (l == 1) {
            LAS int* tab = (LAS int*)lds;
            LAS int* pre = (LAS int*)(lds + MISC_OFF + 256 + 64); LAS int* tsl = (LAS int*)(lds + MISC_OFF + 256 + 128);
            for (int i = tid; i < G * 8; i += NWAVES * 64) tab[i] = CNTWG[i];
            __syncthreads();
            if (tid < 8) { int tot = 0, p = 0; for (int w = 0; w < G; ++w) { const int v = tab[w * 8 + tid]; p += (w < vcu) ? v : 0; tot += v; } pre[tid] = p; pre[8 + tid] = tot; }
            __syncthreads();
            if (tid == 0) { int t = 0; tsl[0] = 0; for (int e = 0; e < 8; ++e) { t += (pre[8 + e] + 255) >> 8; tsl[e + 1] = t; } }
            __syncthreads();
            if (bx == 0 && tid < 9) TSG[tid] = tsl[tid];
            const int per = NTOK / 2048;
            for (int it0 = gw * per; it0 < NTOK; it0 += NGW * per)
            for (int it = it0; it < it0 + per; ++it) {
                const int row = lat_row(it);
#pragma unroll
                for (int k = 0; k < 2; ++k) { const int e = TOK_E[2 * it + k]; const int slot = 256 * tsl[e] + pre[e] + TOK_LP[2 * it + k];
                    const u32x4* s = (const u32x4*)(H8 + (size_t)row * D); u32x4* d = (u32x4*)(HG8 + (size_t)slot * D);
#pragma unroll
                    for (int j = 0; j < 2; ++j) d[64 * j + lane] = s[64 * j + lane];
                    if (lane == 0) { SLOT_W[slot] = TOK_W[2 * it + k]; TOK_SLOT[2 * it + k] = slot; } }
            }
        }
        PH_END_IF(l == 1)

        PH_BEGIN
        {
            LAS int* tsl = (LAS int*)(lds + MISC_OFF + 512);
            if (tid < 9) tsl[tid] = TSG[tid];
            __syncthreads();
            if (l == 0) {
                pg8::Sched S{(const char*)H8, (const char*)(ws + WS_WF1), 2048, 2048, tsl[8], 44, G, bx, 0, 1 << 20, 0, tsl, 0, 0};
                pg8::EpiSwiGLU<false, true> E{ACT, 1.f, (const float*)(ws + T_SA), SWALL + QOFF[0]};
                pg8::gemm_phase<pg8::EpiSwiGLU<false, true>, 2>(lds, S, E, tid);
            } else {
                pg8::Sched S{(const char*)HG8, (const char*)(ws + WS_WM1), 2048, 2048, tsl[8], 44, G, bx, 0, 1 << 20, 0, tsl, (size_t)2 * FF * 2048, 0};
                pg8::EpiSwiGLU<true, false> E{ACT8, 1.f / W8SCALE, nullptr, nullptr};
                pg8::gemm_phase<pg8::EpiSwiGLU<true, false>, 1>(lds, S, E, tid);
            }
        }
        PH_END
        PH_BEGIN
        {
            LAS int* tsl = (LAS int*)(lds + MISC_OFF + 512);
            if (tid < 9) tsl[tid] = TSG[tid];
            __syncthreads();
            if (l == 0) {
                pg8::Sched S{(const char*)ACT, (const char*)(ws + WS_WF2), 2 * FF, 2 * FF, tsl[8], 8, G, bx, 0, 1 << 20, 0, tsl, 0, 0};
                pg8::EpiStore<false> E{FO, 2048, nullptr, 1.f, nullptr, nullptr};
                pg8::gemm_phase<pg8::EpiStore<false>, 0>(lds, S, E, tid);
            } else {
                pg8::Sched S{(const char*)ACT8, (const char*)(ws + WS_WM2), FF, FF, tsl[8], 8, G, bx, 0, 1 << 20, 0, tsl, (size_t)2048 * FF, 0};
                pg8::EpiStore<false> E{FO, 2048, SLOT_W, 1.f / W8SCALE, nullptr, nullptr};
                pg8::gemm_phase<pg8::EpiStore<false>, 1>(lds, S, E, tid);
            }
        }
        PH_END

        PH_BEGIN
        {
            const int per = l == 0 ? M / 2048 : NTOK / 2048; const int nrows = l == 0 ? M : NTOK;
            const float* ng = as_global(a.norm_g) + (size_t)l * 4 * D; const float* mv = MVEC + (size_t)l * 17 * 6 * D;
            const int ln = last_layer ? l : l + 1;
            const float* ngn = as_global(a.norm_g) + (size_t)ln * 4 * D; const float* mvn = MVEC + (size_t)ln * 17 * 6 * D;
            for (int it0 = gw * per; it0 < nrows; it0 += NGW * per)
            for (int it = it0; it < it0 + per; ++it) {
                const int row = l == 0 ? it : lat_row(it);
                const int b = row / TPB, pos = row - b * TPB; const int r = pos < CTXL ? 16 : b;
                const float* mr = mv + (size_t)r * 6 * D; const float* mn = mvn + (size_t)r * 6 * D;
                float yv[32]; float ss = 0.f;
                const bf16* f0 = FO + (size_t)(l == 0 ? row : TOK_SLOT[2 * it]) * D; const bf16* f1 = FO + (size_t)(l == 0 ? row : TOK_SLOT[2 * it + 1]) * D;
#pragma unroll
                for (int j = 0; j < 4; ++j) { float t8[8]; unpack8(*(const u32x4*)(f0 + 512 * j + 8 * lane), t8);
                    if (l == 1) { float u8[8]; unpack8(*(const u32x4*)(f1 + 512 * j + 8 * lane), u8);
#pragma unroll
                        for (int e = 0; e < 8; ++e) t8[e] += u8[e]; }
#pragma unroll
                    for (int e = 0; e < 8; ++e) { yv[8 * j + e] = t8[e]; ss += t8[e] * t8[e]; } }
                const float rstd_y = rsqrtf(wave_sum(ss, lane) * (1.f / D) + EPS);
                bf16* xp = XRES + (size_t)row * D;
                row_update(xp, false, last_layer ? (void*)(as_global(a.out) + (size_t)it * D) : (void*)xp, last_layer, yv, rstd_y, mr + 5 * D, ng + 3 * D, !last_layer, ngn, mn + D, mn, (I8_GATES && (I8_P1 & 2)) ? (bf16*)nullptr : Hb + (size_t)row * D, (I8_GATES || (I8_P1 & 2)) ? HQ + (size_t)row * D : nullptr, (I8_GATES || (I8_P1 & 2)) ? SAH + row : nullptr, lane);
            }
        }
        PH_END
    }
#undef PH_BEGIN
#undef PH_END
#undef PH_END_NB
#undef PH_END_IF
}

constexpr int N_PHASES = 1 + 2 * 16;
#ifndef MK_ONE_LAUNCH
#define MK_ONE_LAUNCH 1
#endif
extern "C" void kernel_launch(void* const* d_in, const int* in_sizes, int n_in, void* d_out, int out_size, void* d_ws, size_t ws_size, hipStream_t stream) {
    static int grid = 0;
    if (grid == 0) {
        if (n_in != 20 || out_size != NTOK * D || ws_size < WS_END) { fprintf(stderr, "kernel_launch: unexpected shapes: n_in %d out %d ws %zu (need %zu)\n", n_in, out_size, ws_size, (size_t)WS_END); grid = -1; return; }
        int dev = 0, cus = 0, per_cu = 0;
        if (hipGetDevice(&dev) != hipSuccess || hipDeviceGetAttribute(&cus, hipDeviceAttributeMultiprocessorCount, dev) != hipSuccess) { grid = -1; return; }
        if (hipFuncSetAttribute((const void*)fwd_kernel, hipFuncAttributeMaxDynamicSharedMemorySize, LDS_BYTES) != hipSuccess) { fprintf(stderr, "kernel_launch: hipFuncSetAttribute failed\n"); grid = -1; return; }
        if (hipOccupancyMaxActiveBlocksPerMultiprocessor(&per_cu, (const void*)fwd_kernel, NWAVES * 64, LDS_BYTES) != hipSuccess || per_cu < 1)
            fprintf(stderr, "kernel_launch: note: occupancy query reports %d workgroups per CU\n", per_cu);
        (void)hipGetLastError();
        grid = cus;
    }
    if (grid < 0) return;
    if (hipMemsetAsync((char*)d_ws + WS_CTL, 0, CTL_ZERO_BYTES, stream) != hipSuccess) { fprintf(stderr, "kernel_launch: memset failed\n"); return; }
    Args a{};
    a.x = (const float*)d_in[0]; a.c = (const float*)d_in[1]; a.ctx = (const float*)d_in[2]; a.c_ctx = (const float*)d_in[3]; a.w_mod = (const float*)d_in[4]; a.b_mod = (const float*)d_in[5];
    a.norm_g = (const float*)d_in[6]; a.w_in = (const float*)d_in[7]; a.qk_g = (const float*)d_in[8]; a.dlam = (const float*)d_in[9]; a.subln = (const float*)d_in[10]; a.rdecay = (const float*)d_in[11];
    a.w_branch = (const float*)d_in[12]; a.w_bgate = (const float*)d_in[13]; a.w_out = (const float*)d_in[14]; a.ffn_w_in = (const float*)d_in[15]; a.ffn_w_out = (const float*)d_in[16];
    a.moe_router = (const float*)d_in[17]; a.moe_w_in = (const float*)d_in[18]; a.moe_w_out = (const float*)d_in[19];
    a.out = (float*)d_out; a.ws = (unsigned char*)d_ws;
#if MK_ONE_LAUNCH
    a.ph_lo = 0; a.ph_hi = N_PHASES;
    hipLaunchKernelGGL(fwd_kernel, dim3(grid), dim3(NWAVES * 64), LDS_BYTES, stream, a);
#else
    for (int p = 0; p < N_PHASES; ++p) { a.ph_lo = p; a.ph_hi = p + 1; hipLaunchKernelGGL(fwd_kernel, dim3(grid), dim3(NWAVES * 64), LDS_BYTES, stream, a); }
#endif
    const hipError_t le = hipPeekAtLastError();
    if (le != hipSuccess) fprintf(stderr, "kernel_launch: launch failed: %s\n", hipGetErrorName(le));
}
```
